# Optimizing an MI355X kernel written in HIP

```python
import jax, jax.numpy as jnp
from jax import lax
import numpy as np

D_MODEL = 1024
BATCH = 2
SEQ = 16384
DEPTH = 2

HG_HEADS = 8
HG_KEY_DIM = 128
HG_VAL_DIM = D_MODEL // HG_HEADS
HG_KEY = HG_HEADS * HG_KEY_DIM
HG_VAL = HG_HEADS * HG_VAL_DIM
HG_CHUNK = 64
SG_GROUPS = 8
SG_GROUP_DIM = 64
SG_WIDTH = SG_GROUPS * SG_GROUP_DIM
SG_CHUNK = 128
FFN_HIDDEN = ((8 * D_MODEL // 3 + 255) // 256) * 256
PLE_DIM = 256
EPS = 1e-6
IN_SPLITS = (HG_KEY, HG_KEY, HG_KEY, HG_VAL, HG_VAL, SG_WIDTH, SG_WIDTH, D_MODEL, D_MODEL)
N_IN = HG_KEY * 3 + HG_VAL * 2 + SG_WIDTH * 2 + D_MODEL * 2

kernel_name = "hgrn2_gmlp_gated_hybrid_encoder"


def rms_norm(x, g):
    xf = x.astype(jnp.float32)
    y = xf * lax.rsqrt(jnp.mean(xf * xf, axis=-1, keepdims=True) + EPS)
    return (y * g.astype(jnp.float32)).astype(x.dtype)


def layer_norm(x, g, b):
    xf = x.astype(jnp.float32)
    mu = jnp.mean(xf, axis=-1, keepdims=True)
    xc = xf - mu
    y = xc * lax.rsqrt(jnp.mean(xc * xc, axis=-1, keepdims=True) + EPS)
    return (y * g.astype(jnp.float32) + b.astype(jnp.float32)).astype(x.dtype)


def layer_lower_bounds(gamma):
    sm = jax.nn.softmax(gamma.astype(jnp.float32), axis=0)
    return jnp.cumsum(sm, axis=0) - sm[0:1]


def _to_chunks(t):
    b, s, h, d = t.shape
    return t.reshape(b, s // HG_CHUNK, HG_CHUNK, h, d).transpose(1, 0, 3, 2, 4)


def hgrn2_direction(q, k, v, logf):
    bsz, s, h, dk = q.shape
    dv = v.shape[-1]
    mask = jnp.tril(jnp.ones((HG_CHUNK, HG_CHUNK), dtype=jnp.float32))

    def step(state, inp):
        qc, kc, vc, gc = inp
        b = jnp.cumsum(gc, axis=2)
        o_inter = jnp.einsum('bhtk,bhkv->bhtv', qc * jnp.exp(b), state)
        diff = b[:, :, :, None, :] - b[:, :, None, :, :]
        decay = jnp.exp(jnp.minimum(diff, 0.0)) * mask[:, :, None]
        scores = jnp.einsum('bhtk,bhsk,bhtsk->bhts', qc, kc, decay)
        o_intra = jnp.einsum('bhts,bhsv->bhtv', scores, vc)
        b_last = b[:, :, -1:, :]
        new_state = (jnp.exp(b_last[:, :, 0, :])[..., None] * state
                     + jnp.einsum('bhsk,bhsv->bhkv', kc * jnp.exp(b_last - b), vc))
        return new_state, o_inter + o_intra

    init = jnp.zeros((bsz, h, dk, dv), jnp.float32)
    _, o = lax.scan(step, init, (_to_chunks(q), _to_chunks(k), _to_chunks(v), _to_chunks(logf)))
    return o.transpose(1, 0, 3, 2, 4).reshape(bsz, s, h, dv)


def hgrn2_mixer(zq, zf_fwd, zf_bwd, zi, zg, lb_f, lb_b, norm_g):
    bsz, s, _ = zq.shape
    f32 = jnp.float32
    tiny = jnp.finfo(f32).tiny
    q = jax.nn.silu(zq.astype(f32)).reshape(bsz, s, HG_HEADS, HG_KEY_DIM)
    v = zi.astype(f32).reshape(bsz, s, HG_HEADS, HG_VAL_DIM)

    def gates(zf, lb):
        zf = zf.astype(f32)
        f = lb + (1.0 - lb) * jax.nn.sigmoid(zf)
        logf = jnp.log(jnp.maximum(f, tiny))
        k = (1.0 - lb) * jax.nn.sigmoid(-zf)
        return (k.reshape(bsz, s, HG_HEADS, HG_KEY_DIM), logf.reshape(bsz, s, HG_HEADS, HG_KEY_DIM))

    k_f, logf_f = gates(zf_fwd, lb_f)
    k_b, logf_b = gates(zf_bwd, lb_b)
    o_fwd = hgrn2_direction(q, k_f, v, logf_f)
    o_bwd = hgrn2_direction(q[:, ::-1], k_b[:, ::-1], v[:, ::-1], logf_b[:, ::-1])[:, ::-1]
    o = o_fwd + o_bwd
    o = rms_norm(o, norm_g.reshape(HG_HEADS, HG_VAL_DIM)).reshape(bsz, s, HG_VAL)
    return (o * jax.nn.silu(zg.astype(f32))).astype(zq.dtype)


def spatial_gating(zu, zv, w_s, b_s, ln_g, ln_b):
    bsz, s, _ = zu.shape
    u = jax.nn.gelu(zu, approximate=False)
    v = layer_norm(jax.nn.gelu(zv, approximate=False), ln_g, ln_b)
    vr = v.reshape(bsz, s // SG_CHUNK, SG_CHUNK, SG_GROUPS, SG_GROUP_DIM)
    sg = jnp.einsum('gts,bcsge->bctge', w_s, vr) + b_s.T[None, None, :, :, None]
    return u * sg.reshape(bsz, s, SG_WIDTH)


def setup_inputs(seed: int = 0) -> dict:
    key = jax.random.key(seed)
    ks = jax.random.split(key, 24)
    f32 = jnp.float32

    def nrm(k, shape, scale):
        return jax.random.normal(k, shape, f32) * scale

    def gain(k, shape):
        return 1.0 + 0.05 * jax.random.normal(k, shape, f32)

    return {
        "x": nrm(ks[0], (BATCH, SEQ, D_MODEL), 1.0),
        "p": nrm(ks[1], (DEPTH, BATCH, SEQ, PLE_DIM), 1.0),
        "norm_mix_pre": gain(ks[2], (DEPTH, D_MODEL)),
        "w_in": nrm(ks[3], (DEPTH, D_MODEL, N_IN), D_MODEL ** -0.5),
        "lb_gamma_fwd": nrm(ks[4], (DEPTH, HG_KEY), 0.1),
        "lb_gamma_bwd": nrm(ks[5], (DEPTH, HG_KEY), 0.1),
        "hg_norm": gain(ks[6], (DEPTH, HG_VAL)),
        "sg_w": nrm(ks[7], (DEPTH, SG_GROUPS, SG_CHUNK, SG_CHUNK), SG_CHUNK ** -0.5),
        "sg_b": gain(ks[8], (DEPTH, SG_GROUPS, SG_CHUNK)),
        "sg_ln_g": gain(ks[9], (DEPTH, SG_WIDTH)),
        "sg_ln_b": nrm(ks[10], (DEPTH, SG_WIDTH), 0.02),
        "w_a": nrm(ks[11], (DEPTH, HG_VAL, D_MODEL), HG_VAL ** -0.5),
        "w_b": nrm(ks[12], (DEPTH, SG_WIDTH, D_MODEL), SG_WIDTH ** -0.5),
        "w_out": nrm(ks[13], (DEPTH, D_MODEL, D_MODEL), D_MODEL ** -0.5),
        "norm_mix_post": gain(ks[14], (DEPTH, D_MODEL)),
        "norm_ffn_pre": gain(ks[15], (DEPTH, D_MODEL)),
        "w_gate": nrm(ks[16], (DEPTH, D_MODEL, FFN_HIDDEN), D_MODEL ** -0.5),
        "w_up": nrm(ks[17], (DEPTH, D_MODEL, FFN_HIDDEN), D_MODEL ** -0.5),
        "w_down": nrm(ks[18], (DEPTH, FFN_HIDDEN, D_MODEL), FFN_HIDDEN ** -0.5),
        "norm_ffn_post": gain(ks[19], (DEPTH, D_MODEL)),
        "w_ple": nrm(ks[20], (DEPTH, PLE_DIM, D_MODEL), PLE_DIM ** -0.5),
        "w_ple_gate": nrm(ks[21], (DEPTH, D_MODEL, D_MODEL), D_MODEL ** -0.5),
    }


def reference(x, p, norm_mix_pre, w_in, lb_gamma_fwd, lb_gamma_bwd, hg_norm, sg_w, sg_b,
              sg_ln_g, sg_ln_b, w_a, w_b, w_out, norm_mix_post, norm_ffn_pre, w_gate, w_up,
              w_down, norm_ffn_post, w_ple, w_ple_gate):
    lb_fwd_all = layer_lower_bounds(lb_gamma_fwd)
    lb_bwd_all = layer_lower_bounds(lb_gamma_bwd)
    offsets = [int(o) for o in np.cumsum(IN_SPLITS)[:-1]]
    for l in range(DEPTH):
        h = rms_norm(x, norm_mix_pre[l])
        z = jnp.einsum('bsd,dn->bsn', h, w_in[l])
        zq, zf_f, zf_b, zi, zg, zu, zv, ga, gb = jnp.split(z, offsets, axis=-1)
        a_out = hgrn2_mixer(zq, zf_f, zf_b, zi, zg, lb_fwd_all[l], lb_bwd_all[l], hg_norm[l])
        b_out = spatial_gating(zu, zv, sg_w[l], sg_b[l], sg_ln_g[l], sg_ln_b[l])
        merged = (jax.nn.sigmoid(ga) * jnp.einsum('bsv,vd->bsd', a_out, w_a[l])
                  + jax.nn.sigmoid(gb) * jnp.einsum('bsw,wd->bsd', b_out, w_b[l]))
        mix = jnp.einsum('bsd,de->bse', merged, w_out[l])
        x = x + rms_norm(mix, norm_mix_post[l])
        h2 = rms_norm(x, norm_ffn_pre[l])
        ff = jnp.einsum('bsf,fd->bsd',
                        jax.nn.silu(jnp.einsum('bsd,df->bsf', h2, w_gate[l]))
                        * jnp.einsum('bsd,df->bsf', h2, w_up[l]), w_down[l])
        x = x + rms_norm(ff, norm_ffn_post[l])
        x = x + (jnp.einsum('bse,ed->bsd', p[l], w_ple[l])
                 * jax.nn.sigmoid(jnp.einsum('bsd,de->bse', x, w_ple_gate[l])))
    return x
```

```cpp
#include <hip/hip_runtime.h>
#include <cstdio>
#include <cstdint>
namespace pg8 {
#define PG8_LAS __attribute__((address_space(3)))
typedef unsigned short bf16_t;
typedef short bf16x8 __attribute__((ext_vector_type(8)));
typedef float f32x4 __attribute__((ext_vector_type(4)));
typedef unsigned u32x4 __attribute__((ext_vector_type(4)));
constexpr int BM = 256, BK = 64, HALF = 128, HTB = HALF * BK * 2  , STAGE_BYTES = 8 * HTB, NXCD = 8, WGM = 4;

__host__ __device__ __forceinline__ int lds_byte(int r, int c) { const int st = (r >> 4) * 2 + (c >> 5), rr = r & 15, cc = c & 31, ob = rr * 64 + cc * 2; return st * 1024 + (ob ^ (((ob >> 9) & 1) << 5)); }
__host__ __device__ __forceinline__ void stage_rc(int b, int& R, int& C) { const int st = b / 1024, sb = b % 1024, swz = sb ^ (((sb >> 9) & 1) << 5); R = (st >> 1) * 16 + swz / 64; C = (st & 1) * 32 + (swz % 64) / 2; }
__host__ __device__ __forceinline__ int perm32(int rho) { const int n = rho >> 4, i = rho & 15; return 8 * (i >> 2) + 4 * n + (i & 3); }

struct Unit { int pm, pn; };
struct Gemm { const bf16_t* A; const bf16_t* Bt; int M, N, K; };

struct StaticOrder {
    int nM, nN, nwg, G, c;
    __host__ __device__ void init(int M, int N, int G_, int c_) { nM = M / BM; nN = N / BM; nwg = nM * nN; G = G_; c = c_; }
    __host__ __device__ bool next(int i, Unit& u) const {
        const long L = (long)i * G + c; if (L >= nwg) return false;
        int wgid = (int)L; { const int q = nwg / NXCD, r = nwg % NXCD, xcd = wgid % NXCD, off = wgid / NXCD; wgid = (xcd < r ? xcd * (q + 1) : r * (q + 1) + (xcd - r) * q) + off; }
        const int nig = WGM * nN, gid = wgid / nig, fm = gid * WGM, gsz = (nM - fm) < WGM ? (nM - fm) : WGM;
        u.pm = fm + ((wgid % nig) % gsz); u.pn = (wgid % nig) / gsz; return true;
    }
    __device__ __forceinline__ void a_ready(const Unit&) const {}
    __device__ __forceinline__ void done(const Unit&) const {}
};

__device__ __forceinline__ unsigned cvt_pk_bf16(float lo, float hi) { unsigned r; asm volatile("v_cvt_pk_bf16_f32 %0, %1, %2" : "=v"(r) : "v"(lo), "v"(hi)); return r; }
template <class Epi, class Sched, bool ALIGN_EPI = false, bool SP2 = false>
__device__ __forceinline__ void gemm_phase(PG8_LAS unsigned char* lds, const Gemm g, const Sched& S, const Epi& E, const int tid) {
    const int wid = __builtin_amdgcn_readfirstlane(tid >> 6), lane = tid & 63, wr = wid >> 2, wc = wid & 3, fr = lane & 15, fq = lane >> 4;
    const int K = g.K, nt = K / BK;
    unsigned voffA[2], voffB[2];
#pragma unroll
    for (int i = 0; i < 2; ++i) { int R, C; stage_rc(tid * 16 + i * 8192, R, C); const int Rb = Epi::PERM ? ((R & ~31) + perm32(R & 31)) : R;
        voffA[i] = (unsigned)(R * K + C) * 2u; voffB[i] = (unsigned)(Rb * K + C) * 2u; }
    const size_t kstep = (size_t)(BK * 2);
    const size_t hstep = (size_t)HALF * K * 2;
    const size_t tstep = 2 * hstep;
    const unsigned ldsw = (unsigned)wid * 1024u;
    const int aoff = lds_byte(wr * 64 + fr, fq * 8), boff = lds_byte(wc * 32 + fr, fq * 8);
#define PG8_SA(b, h) (((b) * 2 + (h)) * HTB)
#define PG8_SB(b, h) ((4 + (b) * 2 + (h)) * HTB)
#define PG8_STAGE(bufoff, gbase, voff) do { _Pragma("unroll") for (int _i = 0; _i < 2; ++_i) \
        __builtin_amdgcn_global_load_lds((const unsigned*)((const char*)(gbase) + (voff)[_i]), (PG8_LAS unsigned*)(lds + (bufoff) + ldsw + _i * 8192), 16, 0, 0); } while (0)
#define PG8_LDA(dst, b, h) do { _Pragma("unroll") for (int m = 0; m < 4; ++m) _Pragma("unroll") for (int k = 0; k < 2; ++k) dst[m][k] = *(const PG8_LAS bf16x8*)(lds + PG8_SA(b, h) + aoff + m * 2048 + k * 1024); } while (0)
#define PG8_LDB(dst, b, h) do { _Pragma("unroll") for (int n = 0; n < 2; ++n) _Pragma("unroll") for (int k = 0; k < 2; ++k) dst[n][k] = *(const PG8_LAS bf16x8*)(lds + PG8_SB(b, h) + boff + n * 2048 + k * 1024); } while (0)
#define PG8_MMA(ai, bj, At, Bt) do { __builtin_amdgcn_s_setprio(1); _Pragma("unroll") for (int m = 0; m < 4; ++m) _Pragma("unroll") for (int n = 0; n < 2; ++n) _Pragma("unroll") for (int k = 0; k < 2; ++k) \
        acc[ai][bj][m][n] = __builtin_amdgcn_mfma_f32_16x16x32_bf16(Bt[n][k], At[m][k], acc[ai][bj][m][n], 0, 0, 0); __builtin_amdgcn_s_setprio(0); } while (0)
#define PG8_WAIT_V(n) asm volatile("s_waitcnt vmcnt(" #n ")" ::: "memory")
#define PG8_WAIT_L(n) asm volatile("s_waitcnt lgkmcnt(" #n ")" ::: "memory")
#define PG8_BAR __builtin_amdgcn_s_barrier()
#define PG8_SCHED __builtin_amdgcn_sched_barrier(0)
    Unit cur, nxt; int ui = 0;
    if (!S.next(0, cur)) return;
    f32x4 acc[2][2][4][2];
#pragma unroll
    for (int a = 0; a < 2; ++a)
#pragma unroll
        for (int b = 0; b < 2; ++b)
#pragma unroll
            for (int m = 0; m < 4; ++m)
#pragma unroll
                for (int n = 0; n < 2; ++n) acc[a][b][m][n] = (f32x4){0.f, 0.f, 0.f, 0.f};
    bf16x8 At[4][2], B0[2][2], B1[2][2];
    const char* cA = (const char*)g.A + (size_t)cur.pm * tstep; const char* cB = (const char*)g.Bt + (size_t)cur.pn * tstep;
    S.a_ready(cur);
    if constexpr (SP2) {
        PG8_STAGE(PG8_SB(0, 0), cB, voffB); PG8_STAGE(PG8_SB(0, 1), cB + hstep, voffB); PG8_STAGE(PG8_SA(0, 0), cA, voffA); PG8_STAGE(PG8_SA(0, 1), cA + hstep, voffA);
        if (wr == 1) PG8_BAR;
        PG8_WAIT_V(2); PG8_BAR;
        PG8_STAGE(PG8_SB(1, 0), cB + kstep, voffB); PG8_STAGE(PG8_SA(1, 0), cA + kstep, voffA); PG8_STAGE(PG8_SB(1, 1), cB + hstep + kstep, voffB);
        PG8_WAIT_V(6); PG8_BAR;
    } else {
        PG8_STAGE(PG8_SB(0, 0), cB, voffB); PG8_STAGE(PG8_SA(0, 0), cA, voffA); PG8_STAGE(PG8_SB(0, 1), cB + hstep, voffB); PG8_STAGE(PG8_SA(0, 1), cA + hstep, voffA);
        if (wr == 1) PG8_BAR;
        PG8_WAIT_V(4); PG8_BAR;
        PG8_STAGE(PG8_SB(1, 0), cB + kstep, voffB); PG8_STAGE(PG8_SA(1, 0), cA + kstep, voffA); PG8_STAGE(PG8_SB(1, 1), cB + hstep + kstep, voffB);
        PG8_WAIT_V(6); PG8_BAR;
    }
    for (;;) {
        const bool has_next = S.next(ui + 1, nxt);
        const char* nA = has_next ? (const char*)g.A + (size_t)nxt.pm * tstep : cA; const char* nB = has_next ? (const char*)g.Bt + (size_t)nxt.pn * tstep : cB;
        for (int t = 0; t < nt; t += 2) {
            const bool last = (t == nt - 2);
            const char* a1 = cA + (size_t)(t + 1) * kstep;
            const char* a2 = last ? nA : cA + (size_t)(t + 2) * kstep; const char* b2 = last ? nB : cB + (size_t)(t + 2) * kstep;
            const char* a3 = a2 + kstep; const char* b3 = b2 + kstep;
            if (last && has_next) S.a_ready(nxt);
            if constexpr (SP2) {
            PG8_LDB(B0, 0, 0); PG8_LDB(B1, 0, 1); PG8_SCHED; PG8_LDA(At, 0, 0); PG8_STAGE(PG8_SA(1, 1), a1 + hstep, voffA);
            PG8_WAIT_V(8); PG8_WAIT_L(0); PG8_BAR; PG8_MMA(0, 0, At, B0); PG8_MMA(0, 1, At, B1); PG8_BAR; PG8_SCHED;
            PG8_LDA(At, 0, 1); PG8_STAGE(PG8_SB(0, 0), b2, voffB); PG8_STAGE(PG8_SB(0, 1), b2 + hstep, voffB); PG8_STAGE(PG8_SA(0, 0), a2, voffA);
            PG8_WAIT_V(8); PG8_WAIT_L(0); PG8_BAR; PG8_MMA(1, 0, At, B0); PG8_MMA(1, 1, At, B1); PG8_BAR; PG8_SCHED;
            PG8_LDB(B0, 1, 0); PG8_LDB(B1, 1, 1); PG8_SCHED; PG8_LDA(At, 1, 0); PG8_STAGE(PG8_SA(0, 1), a2 + hstep, voffA);
            PG8_WAIT_V(8); PG8_WAIT_L(0); PG8_BAR; PG8_MMA(0, 0, At, B0); PG8_MMA(0, 1, At, B1); PG8_BAR; PG8_SCHED;
            PG8_LDA(At, 1, 1); PG8_STAGE(PG8_SB(1, 0), b3, voffB); PG8_STAGE(PG8_SB(1, 1), b3 + hstep, voffB); PG8_STAGE(PG8_SA(1, 0), a3, voffA);
            PG8_WAIT_V(8); PG8_WAIT_L(0); PG8_BAR; PG8_MMA(1, 0, At, B0); PG8_MMA(1, 1, At, B1); PG8_BAR; PG8_SCHED;
            } else {
            PG8_LDB(B0, 0, 0); PG8_SCHED; PG8_LDA(At, 0, 0); PG8_STAGE(PG8_SA(1, 1), a1 + hstep, voffA);
            PG8_WAIT_L(8); PG8_BAR; PG8_WAIT_L(0); PG8_MMA(0, 0, At, B0); PG8_BAR; PG8_SCHED;
            PG8_LDB(B1, 0, 1); PG8_STAGE(PG8_SB(0, 0), b2, voffB);
            PG8_BAR; PG8_WAIT_L(0); PG8_MMA(0, 1, At, B1); PG8_BAR;
            PG8_LDA(At, 0, 1); PG8_STAGE(PG8_SA(0, 0), a2, voffA);
            PG8_BAR; PG8_WAIT_L(0); PG8_MMA(1, 0, At, B0); PG8_BAR; PG8_SCHED;
            PG8_STAGE(PG8_SB(0, 1), b2 + hstep, voffB);
            PG8_WAIT_V(6); PG8_BAR; PG8_MMA(1, 1, At, B1); PG8_BAR;
            PG8_LDB(B0, 1, 0); PG8_SCHED; PG8_LDA(At, 1, 0); PG8_STAGE(PG8_SA(0, 1), a2 + hstep, voffA);
            PG8_WAIT_L(8); PG8_BAR; PG8_WAIT_L(0); PG8_MMA(0, 0, At, B0); PG8_BAR; PG8_SCHED;
            PG8_LDB(B1, 1, 1); PG8_STAGE(PG8_SB(1, 0), b3, voffB);
            PG8_BAR; PG8_WAIT_L(0); PG8_MMA(0, 1, At, B1); PG8_BAR;
            PG8_LDA(At, 1, 1); PG8_STAGE(PG8_SA(1, 0), a3, voffA);
            PG8_BAR; PG8_WAIT_L(0); PG8_MMA(1, 0, At, B0); PG8_BAR; PG8_SCHED;
            PG8_STAGE(PG8_SB(1, 1), b3 + hstep, voffB);
            PG8_WAIT_V(6); PG8_BAR; PG8_MMA(1, 1, At, B1); PG8_BAR;
            }
        }
        if constexpr (ALIGN_EPI) { if (wr == 0) PG8_BAR; }
        if constexpr (!Epi::AFTER_DRAIN) { E(acc, cur, wr, wc, fr, fq); S.done(cur); }
        if (!has_next) break;
#pragma unroll
        for (int a = 0; a < 2; ++a)
#pragma unroll
            for (int b = 0; b < 2; ++b)
#pragma unroll
                for (int m = 0; m < 4; ++m)
#pragma unroll
                    for (int n = 0; n < 2; ++n) acc[a][b][m][n] = (f32x4){0.f, 0.f, 0.f, 0.f};
        cur = nxt; cA = nA; cB = nB; ++ui;
        if constexpr (ALIGN_EPI) { if (wr == 1) PG8_BAR; }
    }
    PG8_WAIT_V(0);
    if constexpr (!ALIGN_EPI) { if (wr == 0) PG8_BAR; }
    PG8_BAR;
    if constexpr (Epi::AFTER_DRAIN) { E.fused(acc, cur, wr, wc, fr, fq, lds, wid, lane); S.done(cur); }
#undef PG8_SA
#undef PG8_SB
#undef PG8_STAGE
#undef PG8_LDA
#undef PG8_LDB
#undef PG8_MMA
#undef PG8_WAIT_V
#undef PG8_WAIT_L
#undef PG8_BAR
#undef PG8_SCHED
}
}

#include <hip/hip_cooperative_groups.h>
namespace cg = cooperative_groups;
#define LAS __attribute__((address_space(3)))
typedef unsigned short bf16;
typedef float f32x4 __attribute__((ext_vector_type(4)));
typedef float f32x16 __attribute__((ext_vector_type(16)));
typedef short bf16x8 __attribute__((ext_vector_type(8)));
typedef unsigned u32x4 __attribute__((ext_vector_type(4)));
typedef unsigned u32x2 __attribute__((ext_vector_type(2)));
typedef float f32x2 __attribute__((ext_vector_type(2)));
#define MFMA32(a, b, c) __builtin_amdgcn_mfma_f32_32x32x16_bf16((a), (b), (c), 0, 0, 0)

constexpr int T = 32768, TB = 16384, D = 1024, NIN = 8192, FF = 2816, PLE = 256, SGWD = 512;
constexpr int NSEG = 32, SEGCH = 8;
constexpr float EPS = 1e-6f;
constexpr size_t MiB = 1u << 20;
constexpr size_t WS_LBT = 0;
constexpr size_t WS_DSEG = 64 * 1024;
constexpr size_t WS_SGW = 1 * MiB;
constexpr size_t WS_W = 2 * MiB;
constexpr size_t W_IN = WS_W, W_A = WS_W + 16 * MiB, W_B = WS_W + 18 * MiB, W_O = WS_W + 19 * MiB, W_GU = WS_W + 21 * MiB,
                 W_DN = WS_W + 32 * MiB, W_PG = WS_W + 32 * MiB + 5632 * 1024, W_PL = W_PG + 2 * MiB;
constexpr size_t WS_H = 42 * MiB;
constexpr size_t WS_MIX = 74 * MiB;
constexpr size_t WS_R = 138 * MiB;
constexpr size_t WS_Q = WS_R, WS_LF = WS_R + 32 * MiB, WS_LB = WS_R + 64 * MiB, WS_V = WS_R + 96 * MiB, WS_ZG = WS_R + 128 * MiB,
                 WS_U = WS_R + 160 * MiB, WS_GV = WS_R + 176 * MiB, WS_SA = WS_R + 192 * MiB, WS_SB = WS_R + 224 * MiB,
                 WS_BO = WS_R + 256 * MiB, WS_AO = WS_R + 272 * MiB, WS_SEG = WS_R + 304 * MiB;
constexpr size_t WS_HID = WS_R, WS_H2 = WS_R + 176 * MiB, WS_PB = WS_R + 240 * MiB;
constexpr size_t WS_PB2 = WS_R + 336 * MiB;
constexpr size_t WS_END = WS_R + 352 * MiB;
static_assert(W_PL + 1024 * 256 * 2 <= WS_H, "weights map");

constexpr int LDS_BYTES = 143360;

__device__ __forceinline__ float bf2f(unsigned b) { return __uint_as_float(b << 16); }
__device__ __forceinline__ unsigned f2bf(float f) { unsigned u = __float_as_uint(f); return (u + 0x7fffu + ((u >> 16) & 1u)) >> 16; }
typedef __bf16 bf16x2_t __attribute__((ext_vector_type(2)));
__device__ __forceinline__ unsigned pk2(float lo, float hi) { f32x2 v = {lo, hi}; bf16x2_t b = __builtin_convertvector(v, bf16x2_t); return __builtin_bit_cast(unsigned, b); }
__device__ __forceinline__ float sigm(float x) { return __builtin_amdgcn_rcpf(1.f + __builtin_amdgcn_exp2f(-1.44269504089f * x)); }
__device__ __forceinline__ float siluf(float x) { return x * sigm(x); }
__device__ __forceinline__ float geluf(float v) {
    const float av = fabsf(v), d = av * 0.2316418882f + 1.0f; const float t = __builtin_amdgcn_rcpf(d);
    float q = t * 0.5307027145f + (-0.7265760135f); q = q * t + 0.7107068705f; q = q * t + (-0.142248368f); q = q * t + 0.127414796f; q = q * t;
    const float e = __builtin_amdgcn_exp2f((v * v) * (-0.72134752044f));
    const float m = v * (q * e); return v < 0.f ? m : v - m; }
__device__ __forceinline__ unsigned f2h(float x) { _Float16 h = (_Float16)x; return (unsigned)__builtin_bit_cast(unsigned short, h); }
__device__ __forceinline__ float h2f(unsigned short b) { return (float)__builtin_bit_cast(_Float16, b); }
__device__ __forceinline__ void st8bf(bf16* p, f32x4 lo, f32x4 hi) {
    u32x4 w; w.x = pk2(lo[0], lo[1]); w.y = pk2(lo[2], lo[3]); w.z = pk2(hi[0], hi[1]); w.w = pk2(hi[2], hi[3]); *(u32x4*)p = w; }
__device__ __forceinline__ void ld8bf(const bf16* p, f32x4& lo, f32x4& hi) {
    const u32x4 w = *(const u32x4*)p;
    lo[0] = __uint_as_float(w.x << 16); lo[1] = __uint_as_float(w.x & 0xffff0000u); lo[2] = __uint_as_float(w.y << 16); lo[3] = __uint_as_float(w.y & 0xffff0000u);
    hi[0] = __uint_as_float(w.z << 16); hi[1] = __uint_as_float(w.z & 0xffff0000u); hi[2] = __uint_as_float(w.w << 16); hi[3] = __uint_as_float(w.w & 0xffff0000u); }
template <int CTRL> __device__ __forceinline__ float dppf(float v) { return __int_as_float(__builtin_amdgcn_update_dpp(0, __float_as_int(v), CTRL, 0xf, 0xf, true)); }
__device__ __forceinline__ float row16_sum(float v) {
    v += dppf<0xB1>(v);
    v += dppf<0x4E>(v);
    v += dppf<0x141>(v);
    v += dppf<0x140>(v);
    return v;
}
__device__ __forceinline__ float wave_sum(float v) {
    v = row16_sum(v);
    v += __shfl_xor(v, 16); v += __shfl_xor(v, 32);
    return v;
}

template <class F> struct EpiRow8 {
    static constexpr bool PERM = true, AFTER_DRAIN = false;
    F f;
    __device__ __forceinline__ void operator()(const pg8::f32x4 (&acc)[2][2][4][2], const pg8::Unit& u, int wr, int wc, int fr, int fq) const {
        { int t_ = threadIdx.x; asm volatile("" : "+v"(t_)); const int w_ = __builtin_amdgcn_readfirstlane(t_ >> 6), l_ = t_ & 63; wr = w_ >> 2; wc = w_ & 3; fr = l_ & 15; fq = l_ >> 4; }
        unsigned char* w = f.ws; asm volatile("" : "+s"(w));
#pragma unroll
        for (int ai = 0; ai < 2; ++ai)
#pragma unroll
            for (int m = 0; m < 4; ++m) {
                const int row = u.pm * 256 + ai * 128 + wr * 64 + m * 16 + fr;
#pragma unroll
                for (int bj = 0; bj < 2; ++bj) {
                    const int col = u.pn * 256 + bj * 128 + wc * 32 + 8 * fq;
                    f(w, row, col, acc[ai][bj][m][0], acc[ai][bj][m][1]);
                }
            }
    }
};
struct EpiSwiglu {
    static constexpr bool PERM = true, AFTER_DRAIN = false;
    unsigned char* ws;
    __device__ __forceinline__ void operator()(const pg8::f32x4 (&acc)[2][2][4][2], const pg8::Unit& u, int wr, int wc, int fr, int fq) const {
        { int t_ = threadIdx.x; asm volatile("" : "+v"(t_)); const int w_ = __builtin_amdgcn_readfirstlane(t_ >> 6), l_ = t_ & 63; wr = w_ >> 2; wc = w_ & 3; fr = l_ & 15; fq = l_ >> 4; }
        unsigned char* w = ws; asm volatile("" : "+s"(w));
        bf16* HID = (bf16*)(w + WS_HID);
#pragma unroll
        for (int ai = 0; ai < 2; ++ai)
#pragma unroll
            for (int m = 0; m < 4; ++m) {
                const int row = u.pm * 256 + ai * 128 + wr * 64 + m * 16 + fr;
                const int hcol = u.pn * 128 + wc * 32 + 8 * fq;
                f32x4 lo, hi;
#pragma unroll
                for (int i = 0; i < 4; ++i) { lo[i] = siluf(acc[ai][0][m][0][i]) * acc[ai][1][m][0][i]; hi[i] = siluf(acc[ai][0][m][1][i]) * acc[ai][1][m][1][i]; }
                st8bf(HID + (size_t)row * FF + hcol, lo, hi);
            }
    }
};

struct EpiG1 {
    static constexpr bool PERM = true, AFTER_DRAIN = false;
    unsigned char* ws; int lb0;
    template <int KIND> __device__ __forceinline__ void seg(unsigned char* w, size_t dst, int ld, int cbase, const float* lb, const pg8::f32x4 (&acc)[2][2][4][2], const pg8::Unit& u, int wr, int wc, int fr, int fq) const {
#pragma unroll
        for (int ai = 0; ai < 2; ++ai)
#pragma unroll
            for (int m = 0; m < 4; ++m) {
                const int row = u.pm * 256 + ai * 128 + wr * 64 + m * 16 + fr;
#pragma unroll
                for (int bj = 0; bj < 2; ++bj) {
                    const int c = u.pn * 256 + bj * 128 + wc * 32 + 8 * fq - cbase;
                    f32x4 lo = acc[ai][bj][m][0], hi = acc[ai][bj][m][1];
                    if (KIND == 4) {
                        const f32x4 l0 = *(const f32x4*)(lb + c), l1 = *(const f32x4*)(lb + c + 4);
                        float r[8];
                        if (lb0) {
#pragma unroll
                            for (int i = 0; i < 4; ++i) {
                                r[i] = fmaxf(-__log2f(1.f + __builtin_amdgcn_exp2f(-1.44269504089f * lo[i])), -126.f);
                                r[4 + i] = fmaxf(-__log2f(1.f + __builtin_amdgcn_exp2f(-1.44269504089f * hi[i])), -126.f);
                            }
                        } else {
#pragma unroll
                        for (int i = 0; i < 4; ++i) {
                            const float f0 = l0[i] + (1.f - l0[i]) * sigm(lo[i]); r[i] = __log2f(fmaxf(f0, 1.17549435e-38f));
                            const float f1 = l1[i] + (1.f - l1[i]) * sigm(hi[i]); r[4 + i] = __log2f(fmaxf(f1, 1.17549435e-38f));
                        }
                        }
                        u32x4 v; v.x = f2h(r[0]) | (f2h(r[1]) << 16); v.y = f2h(r[2]) | (f2h(r[3]) << 16); v.z = f2h(r[4]) | (f2h(r[5]) << 16); v.w = f2h(r[6]) | (f2h(r[7]) << 16);
                        *(u32x4*)((unsigned short*)(w + dst) + (size_t)row * ld + c) = v;
                    } else {
#pragma unroll
                        for (int i = 0; i < 4; ++i) {
                            if (KIND == 1) { lo[i] = siluf(lo[i]); hi[i] = siluf(hi[i]); }
                            if (KIND == 2) { lo[i] = geluf(lo[i]); hi[i] = geluf(hi[i]); }
                            if (KIND == 3) { lo[i] = sigm(lo[i]); hi[i] = sigm(hi[i]); }
                        }
                        st8bf((bf16*)(w + dst) + (size_t)row * ld + c, lo, hi);
                    }
                }
            }
    }
    __device__ __forceinline__ void operator()(const pg8::f32x4 (&acc)[2][2][4][2], const pg8::Unit& u, int wr, int wc, int fr, int fq) const {
        { int t_ = threadIdx.x; asm volatile("" : "+v"(t_)); const int w_ = __builtin_amdgcn_readfirstlane(t_ >> 6), l_ = t_ & 63; wr = w_ >> 2; wc = w_ & 3; fr = l_ & 15; fq = l_ >> 4; }
        unsigned char* w = ws; asm volatile("" : "+s"(w));
        const int sg = u.pn >> 1;
        const float* lbt = (const float*)(w + WS_LBT);
        if (sg < 2) seg<1>(w, WS_Q, D, 0, nullptr, acc, u, wr, wc, fr, fq);
        else if (sg < 4) seg<4>(w, WS_LF, D, 1024, lbt, acc, u, wr, wc, fr, fq);
        else if (sg < 6) seg<4>(w, WS_LB, D, 2048, lbt + 1024, acc, u, wr, wc, fr, fq);
        else if (sg < 8) seg<0>(w, WS_V, D, 3072, nullptr, acc, u, wr, wc, fr, fq);
        else if (sg < 10) seg<1>(w, WS_ZG, D, 4096, nullptr, acc, u, wr, wc, fr, fq);
        else if (sg == 10) seg<2>(w, WS_U, SGWD, 5120, nullptr, acc, u, wr, wc, fr, fq);
        else if (sg == 11) seg<2>(w, WS_GV, SGWD, 5632, nullptr, acc, u, wr, wc, fr, fq);
        else if (sg < 14) seg<3>(w, WS_SA, D, 6144, nullptr, acc, u, wr, wc, fr, fq);
        else seg<3>(w, WS_SB, D, 7168, nullptr, acc, u, wr, wc, fr, fq);
    }
};
struct FG2 { unsigned char* ws;
    __device__ __forceinline__ void operator()(unsigned char* w, int row, int col, f32x4 lo, f32x4 hi) const {
        f32x4 a, b; ld8bf((const bf16*)(w + WS_SA) + (size_t)row * D + col, a, b); st8bf((bf16*)(w + WS_Q) + (size_t)row * D + col, lo * a, hi * b); } };
struct FG3 { unsigned char* ws;
    __device__ __forceinline__ void operator()(unsigned char* w, int row, int col, f32x4 lo, f32x4 hi) const {
        f32x4 a, b, c, d; ld8bf((const bf16*)(w + WS_SB) + (size_t)row * D + col, a, b); bf16* m1 = (bf16*)(w + WS_Q) + (size_t)row * D + col; ld8bf(m1, c, d); st8bf(m1, c + lo * a, d + hi * b); } };
struct FStore { unsigned char* ws; size_t off;
    __device__ __forceinline__ void operator()(unsigned char* w, int row, int col, f32x4 lo, f32x4 hi) const { st8bf((bf16*)(w + off) + (size_t)row * D + col, lo, hi); } };
struct FSig { unsigned char* ws;
    __device__ __forceinline__ void operator()(unsigned char* w, int row, int col, f32x4 lo, f32x4 hi) const {
#pragma unroll
        for (int i = 0; i < 4; ++i) { lo[i] = sigm(lo[i]); hi[i] = sigm(hi[i]); }
        st8bf((bf16*)(w + WS_MIX) + (size_t)row * D + col, lo, hi); } };
struct FG8 { unsigned char* ws; float* X;
    __device__ __forceinline__ void operator()(unsigned char* w, int row, int col, f32x4 lo, f32x4 hi) const {
        f32x4 a, b; ld8bf((const bf16*)(w + WS_MIX) + (size_t)row * D + col, a, b);
        float* xp = X + (size_t)row * D + col; const f32x4 x0 = *(const f32x4*)xp, x1 = *(const f32x4*)(xp + 4);
        *(f32x4*)xp = x0 + lo * a; *(f32x4*)(xp + 4) = x1 + hi * b; } };

template <class Epi, bool ALIGN = true> __device__ __forceinline__ void run_gemm(LAS unsigned char* lds, const bf16* A, const bf16* Bt, int M, int N, int K, const Epi& E, int tid, int bid) {
    pg8::Gemm g{A, Bt, M, N, K}; pg8::StaticOrder S; S.init(M, N, (int)gridDim.x, bid);
    pg8::gemm_phase<Epi, pg8::StaticOrder, ALIGN, true>(lds, g, S, E, tid);
}

__device__ __forceinline__ void transpose_item(const float* W, int K, int N, bf16* WT, int mode, LAS float* scr, int item, int lane) {
    const int nblk = N / 32, kb = item / nblk, nb = item % nblk, k0 = 64 * kb, n0 = 32 * nb;
    const int r0 = mode == 0 ? n0 : (256 * (n0 >> 7) + (n0 & 127) + (mode == 2 ? 128 : 0));
#pragma unroll 8
    for (int i = 0; i < 32; ++i) { const int kk = 2 * i + (lane >> 5); scr[kk * 33 + (lane & 31)] = __builtin_nontemporal_load(W + (size_t)(k0 + kk) * N + n0 + (lane & 31)); }
    asm volatile("s_waitcnt lgkmcnt(0)" ::: "memory");
    const int c = lane & 7;
#pragma unroll
    for (int j = 0; j < 4; ++j) { const int n = (lane >> 3) + 8 * j; const LAS float* s = scr + (8 * c) * 33 + n;
        u32x4 o; o.x = pk2(s[0 * 33], s[1 * 33]); o.y = pk2(s[2 * 33], s[3 * 33]); o.z = pk2(s[4 * 33], s[5 * 33]); o.w = pk2(s[6 * 33], s[7 * 33]);
        *(u32x4*)(WT + (size_t)(r0 + n) * K + k0 + 8 * c) = o; }
    asm volatile("s_waitcnt lgkmcnt(0)" ::: "memory");
}

struct Args { const float* in[22]; float* out; unsigned char* ws; int ph_lo, ph_hi; };

__device__ __forceinline__ void prologue(const __attribute__((address_space(4))) Args* a, unsigned char* ws, int l, LAS unsigned char* lds, int tid, int wave, int lane) {
    LAS float* scr = (LAS float*)(lds + wave * 16384);
    const int gw = blockIdx.x * 8 + wave, NGW = gridDim.x * 8;
    constexpr int I_IN = 16 * 256, I_A = 16 * 32, I_B = 8 * 32, I_O = 16 * 32, I_G = 16 * 88, I_D = 44 * 32, I_PG = 16 * 32, I_PL = 4 * 32;
    constexpr int NIT = I_IN + I_A + I_B + I_O + 2 * I_G + I_D + I_PG + I_PL;
    for (int it = gw; it < NIT; it += NGW) {
        int r = it;
        if (r < I_IN) { transpose_item(a->in[3] + (size_t)l * D * NIN, D, NIN, (bf16*)(ws + W_IN), 0, scr, r, lane); continue; } r -= I_IN;
        if (r < I_A) { transpose_item(a->in[11] + (size_t)l * D * D, D, D, (bf16*)(ws + W_A), 0, scr, r, lane); continue; } r -= I_A;
        if (r < I_B) { transpose_item(a->in[12] + (size_t)l * SGWD * D, SGWD, D, (bf16*)(ws + W_B), 0, scr, r, lane); continue; } r -= I_B;
        if (r < I_O) { transpose_item(a->in[13] + (size_t)l * D * D, D, D, (bf16*)(ws + W_O), 0, scr, r, lane); continue; } r -= I_O;
        if (r < I_G) { transpose_item(a->in[16] + (size_t)l * D * FF, D, FF, (bf16*)(ws + W_GU), 1, scr, r, lane); continue; } r -= I_G;
        if (r < I_G) { transpose_item(a->in[17] + (size_t)l * D * FF, D, FF, (bf16*)(ws + W_GU), 2, scr, r, lane); continue; } r -= I_G;
        if (r < I_D) { transpose_item(a->in[18] + (size_t)l * FF * D, FF, D, (bf16*)(ws + W_DN), 0, scr, r, lane); continue; } r -= I_D;
        if (r < I_PG) { transpose_item(a->in[21] + (size_t)l * D * D, D, D, (bf16*)(ws + W_PG), 0, scr, r, lane); continue; } r -= I_PG;
        transpose_item(a->in[20] + (size_t)l * PLE * D, PLE, D, (bf16*)(ws + W_PL), 0, scr, r, lane);
    }
    const int gt = blockIdx.x * 512 + tid, NGT = gridDim.x * 512;
    for (int i = gt; i < 2048; i += NGT) {
        const float* gm = a->in[i < 1024 ? 4 : 5]; const int c = i & 1023;
        ((float*)(ws + WS_LBT))[i] = (l == 0) ? 0.f : 1.f / (1.f + __expf(gm[c] - gm[1024 + c]));
    }
    for (int i = gt; i < 8 * 128 * 128 / 2; i += NGT) {
        const float* s = a->in[7] + (size_t)l * 131072 + 2 * i;
        ((unsigned*)(ws + WS_SGW))[i] = pk2(s[0], s[1]);
    }
}

__device__ __forceinline__ void ldrow8(const float* p, f32x4& a, f32x4& b) { a = *(const f32x4*)p; b = *(const f32x4*)(p + 4); }
__device__ __forceinline__ float sq8(const f32x4& a, const f32x4& b) { return (a[0] * a[0] + a[1] * a[1]) + (a[2] * a[2] + a[3] * a[3]) + (b[0] * b[0] + b[1] * b[1]) + (b[2] * b[2] + b[3] * b[3]); }
__device__ __forceinline__ void rows_r0(const float* xin, const float* g, bf16* H, int row0, int nrows, int wave, int lane) {
    const int gw = blockIdx.x * 8 + wave, NGW = gridDim.x * 8;
    f32x4 ga[2], gb[2];
#pragma unroll
    for (int j = 0; j < 2; ++j) ldrow8(g + 8 * lane + 512 * j, ga[j], gb[j]);
    for (int m = gw; m < nrows; m += NGW) {
        const float* xr = xin + (size_t)(row0 + m) * D + 8 * lane; f32x4 va[2], vb[2]; float s = 0.f;
#pragma unroll
        for (int j = 0; j < 2; ++j) { ldrow8(xr + 512 * j, va[j], vb[j]); s += sq8(va[j], vb[j]); }
        const float r = rsqrtf(wave_sum(s) * (1.f / D) + EPS);
        bf16* o = H + (size_t)m * D + 8 * lane;
#pragma unroll
        for (int j = 0; j < 2; ++j) st8bf(o + 512 * j, va[j] * r * ga[j], vb[j] * r * gb[j]);
    }
}
__device__ __forceinline__ void rows_r12(const float* xin, float* xout, const bf16* Y, const float* g1, const float* g2, bf16* Hout, const float* prow, bf16* PB, int wave, int lane) {
    const int gw = blockIdx.x * 8 + wave, NGW = gridDim.x * 8;
    for (int m = gw; m < T; m += NGW) {
        const float* xr = xin + (size_t)m * D + 8 * lane; const bf16* yr = Y + (size_t)m * D + 8 * lane;
        f32x4 va[2], vb[2], ya[2], yb[2]; float s = 0.f;
#pragma unroll
        for (int j = 0; j < 2; ++j) { ldrow8(xr + 512 * j, va[j], vb[j]); ld8bf(yr + 512 * j, ya[j], yb[j]); s += sq8(ya[j], yb[j]); }
        f32x4 pv; if (prow) pv = *(const f32x4*)(prow + (size_t)m * PLE + 4 * lane);
        const float r = rsqrtf(wave_sum(s) * (1.f / D) + EPS);
        float s2 = 0.f;
#pragma unroll
        for (int j = 0; j < 2; ++j) { f32x4 ga, gb; ldrow8(g1 + 8 * lane + 512 * j, ga, gb); va[j] = va[j] + ya[j] * r * ga; vb[j] = vb[j] + yb[j] * r * gb;
            float* xo = xout + (size_t)m * D + 8 * lane + 512 * j; *(f32x4*)xo = va[j]; *(f32x4*)(xo + 4) = vb[j];
            s2 += sq8(va[j], vb[j]); }
        bf16* o = Hout + (size_t)m * D + 8 * lane;
        if (g2) {
            const float r2 = rsqrtf(wave_sum(s2) * (1.f / D) + EPS);
#pragma unroll
            for (int j = 0; j < 2; ++j) { f32x4 ga, gb; ldrow8(g2 + 8 * lane + 512 * j, ga, gb); st8bf(o + 512 * j, va[j] * r2 * ga, vb[j] * r2 * gb); }
        } else {
#pragma unroll
            for (int j = 0; j < 2; ++j) st8bf(o + 512 * j, va[j], vb[j]);
        }
        if (prow) { u32x2 w; w.x = pk2(pv[0], pv[1]); w.y = pk2(pv[2], pv[3]); *(u32x2*)(PB + (size_t)m * PLE + 4 * lane) = w; }
    }
}

constexpr int LDQ = 136, LDT = 72, LDSTG = 132;
constexpr int L_QD = 0, L_QS = 17408, L_KS = 34816, L_KDT = 52224, L_VT = 70656, L_ST = 89088, L_P = 123904, L_TOT = 133120, L_DV = 137216, L_RS = 137728;
static_assert(L_RS + 1024 <= LDS_BYTES - 16 && 64 * LDSTG * 4 <= L_KDT - L_QS, "lds map");
__device__ __forceinline__ int rowf(int reg, int hh) { return (reg & 3) + 8 * (reg >> 2) + 4 * hh; }

#define LBAR() asm volatile("s_waitcnt lgkmcnt(0)\n\ts_barrier" ::: "memory")
template <bool OUT>
__device__ __forceinline__ void scan_item(LAS unsigned char* lds, unsigned char* ws, const float* hgn_l, int item, int tid_in, int wid, int lane_in) {
    const int h = item / NSEG, seg = item % NSEG;
    float* SEG = (float*)(ws + WS_SEG); float* DSEG = (float*)(ws + WS_DSEG);
    const bf16* Qp = (const bf16*)(ws + WS_Q); const bf16* Vp = (const bf16*)(ws + WS_V); bf16* AOp = (bf16*)(ws + WS_AO); const bf16* ZGp = (const bf16*)(ws + WS_ZG);
    LAS unsigned short* QD = (LAS unsigned short*)(lds + L_QD); LAS unsigned short* QS = (LAS unsigned short*)(lds + L_QS); LAS unsigned short* KS = (LAS unsigned short*)(lds + L_KS);
    LAS float* TOT = (LAS float*)(lds + L_TOT); LAS float* DV = (LAS float*)(lds + L_DV); LAS float* RS = (LAS float*)(lds + L_RS);
    for (int dir = 0; dir < 2; ++dir) {
        if (OUT && dir == 1) __syncthreads();
        int tid = tid_in, lane = lane_in;
        asm volatile("" : "+v"(tid), "+v"(lane));
        f32x16 S[2];
        float* sp = SEG + (size_t)((h * 2 + dir) * NSEG + seg) * 16384;
        {
            const int r = lane & 31, hh = lane >> 5, kb = wid >> 1;
#pragma unroll
            for (int j = 0; j < 2; ++j) { const int vc = (2 * (wid & 1) + j) * 32 + r;
#pragma unroll
                for (int i = 0; i < 16; ++i) S[j][i] = OUT ? sp[(kb * 32 + rowf(i, hh)) * 128 + vc] : 0.f; }
        }
        const unsigned short* LFp = (const unsigned short*)(ws + (dir ? WS_LB : WS_LF));
        unsigned lraw[8], vraw[8], qraw[8];
        float dsa = 0.f, dsb = 0.f;
        const int es = dir ? -D : D;
        {
            const int c = seg * SEGCH + (dir ? SEGCH - 1 : 0);
            const unsigned e0 = (unsigned)((c * 64 + (dir ? 63 - wid * 8 : wid * 8)) * D + h * 128 + 2 * lane);
#pragma unroll
            for (int i = 0; i < 8; ++i) lraw[i] = *(const unsigned*)(LFp + (e0 + (unsigned)(i * es)));
#pragma unroll
            for (int i = 0; i < 8; ++i) vraw[i] = *(const unsigned*)(Vp + (e0 + (unsigned)(i * es)));
            if (OUT) {
#pragma unroll
                for (int i = 0; i < 8; ++i) qraw[i] = *(const unsigned*)(Qp + (e0 + (unsigned)(i * es)));
            }
        }
        for (int ci = 0; ci < SEGCH; ++ci) {
            asm volatile("" : "+v"(tid), "+v"(lane));
            const int r = lane & 31, hh = lane >> 5;
            const int c = seg * SEGCH + (dir ? SEGCH - 1 - ci : ci), tok0 = c * 64;
            if (OUT) {
                const int kb = wid >> 1;
#pragma unroll
                for (int j = 0; j < 2; ++j) { const int vcol = (2 * (wid & 1) + j) * 32 + r;
#pragma unroll
                    for (int g = 0; g < 4; ++g) { u32x2 w; w.x = pk2(S[j][4 * g], S[j][4 * g + 1]); w.y = pk2(S[j][4 * g + 2], S[j][4 * g + 3]);
                        *(LAS u32x2*)(lds + L_ST + (vcol * LDQ + kb * 32 + 8 * g + 4 * hh) * 2) = w; } }
            }
            float bla[8], blb[8], lfa[8], lfb[8]; float runa = 0.f, runb = 0.f;
#pragma unroll
            for (int i = 0; i < 8; ++i) { lfa[i] = h2f((unsigned short)(lraw[i] & 0xffffu)); lfb[i] = h2f((unsigned short)(lraw[i] >> 16)); runa += lfa[i]; runb += lfb[i]; bla[i] = runa; blb[i] = runb; }
            *(LAS f32x2*)(TOT + wid * 128 + 2 * lane) = (f32x2){runa, runb};
            LBAR();
            float offa = 0.f, offb = 0.f, bma = 0.f, bmb = 0.f, bta = 0.f, btb = 0.f;
#pragma unroll
            for (int p = 0; p < 8; ++p) { const f32x2 t = *(const LAS f32x2*)(TOT + p * 128 + 2 * lane);
                if (p < wid) { offa += t[0]; offb += t[1]; } if (p < 4) { bma += t[0]; bmb += t[1]; } bta += t[0]; btb += t[1]; }
            const float c1a = __builtin_amdgcn_exp2f(bta - bma), c1b = __builtin_amdgcn_exp2f(btb - bmb), c2a = __builtin_amdgcn_exp2f(bma), c2b = __builtin_amdgcn_exp2f(bmb);
            float kda[8], kdb[8];
#pragma unroll
            for (int i = 0; i < 8; ++i) {
                const float ba = bla[i] + offa, bb = blb[i] + offb;
                const float kka = 1.f - __builtin_amdgcn_exp2f(lfa[i]), kkb = 1.f - __builtin_amdgcn_exp2f(lfb[i]);
                if (OUT) {
                    const int tau = wid * 8 + i;
                    const float qa = __uint_as_float(qraw[i] << 16), qb = __uint_as_float(qraw[i] & 0xffff0000u);
                    const float qsa = qa * __builtin_amdgcn_exp2f(fminf(ba - bma, 115.f)), qsb = qb * __builtin_amdgcn_exp2f(fminf(bb - bmb, 115.f));
                    const float ksa = kka * __builtin_amdgcn_exp2f(fminf(bma - ba, 115.f)), ksb = kkb * __builtin_amdgcn_exp2f(fminf(bmb - bb, 115.f));
                    kda[i] = ksa * c1a; kdb[i] = ksb * c1b;
                    *(LAS unsigned*)(lds + L_QD + (tau * LDQ + 2 * lane) * 2) = pk2(qsa * c2a, qsb * c2b);
                    *(LAS unsigned*)(lds + L_QS + (tau * LDQ + 2 * lane) * 2) = pk2(qsa, qsb);
                    *(LAS unsigned*)(lds + L_KS + (tau * LDQ + 2 * lane) * 2) = pk2(ksa, ksb);
                } else {
                    kda[i] = kka * __builtin_amdgcn_exp2f(bta - ba); kdb[i] = kkb * __builtin_amdgcn_exp2f(btb - bb);
                }
            }
            {
                LAS u32x4* kp = (LAS u32x4*)(lds + L_KDT + ((2 * lane) * LDT + wid * 8) * 2); LAS u32x4* vp = (LAS u32x4*)(lds + L_VT + ((2 * lane) * LDT + wid * 8) * 2);
                kp[0] = (u32x4){pk2(kda[0], kda[1]), pk2(kda[2], kda[3]), pk2(kda[4], kda[5]), pk2(kda[6], kda[7])};
                kp[LDT * 2 / 16] = (u32x4){pk2(kdb[0], kdb[1]), pk2(kdb[2], kdb[3]), pk2(kdb[4], kdb[5]), pk2(kdb[6], kdb[7])};
                u32x4 va, vb;
#pragma unroll
                for (int j = 0; j < 4; ++j) { va[j] = (vraw[2 * j] & 0xffffu) | (vraw[2 * j + 1] << 16); vb[j] = (vraw[2 * j] >> 16) | (vraw[2 * j + 1] & 0xffff0000u); }
                vp[0] = va; vp[LDT * 2 / 16] = vb;
            }
            if (wid == 0) { *(LAS f32x2*)(DV + 2 * lane) = (f32x2){__builtin_amdgcn_exp2f(bta), __builtin_amdgcn_exp2f(btb)}; dsa += bta; dsb += btb; }
            if (ci + 1 < SEGCH) {
                const int cn = seg * SEGCH + (dir ? SEGCH - 2 - ci : ci + 1);
                const unsigned e0 = (unsigned)((cn * 64 + (dir ? 63 - wid * 8 : wid * 8)) * D + h * 128 + 2 * lane);
#pragma unroll
                for (int i = 0; i < 8; ++i) lraw[i] = *(const unsigned*)(LFp + (e0 + (unsigned)(i * es)));
#pragma unroll
                for (int i = 0; i < 8; ++i) vraw[i] = *(const unsigned*)(Vp + (e0 + (unsigned)(i * es)));
                if (OUT) {
#pragma unroll
                    for (int i = 0; i < 8; ++i) qraw[i] = *(const unsigned*)(Qp + (e0 + (unsigned)(i * es)));
                }
            }
            u32x4 aoraw[2], zgraw[2];
            const int otb = wid >> 2, ovb = wid & 3, ovc = ovb * 32 + r;
            const int ftau = tid >> 4, fv0 = 8 * (tid & 15);
            if (OUT && dir == 1) {
#pragma unroll
                for (int j = 0; j < 2; ++j) { const unsigned ad = (unsigned)((tok0 + 63 - (ftau + 32 * j)) * D + h * 128 + fv0); aoraw[j] = *(const u32x4*)(AOp + ad); zgraw[j] = *(const u32x4*)(ZGp + ad); }
            }
            LBAR();
            if (OUT) {
                if (wid < 4) {
                    const int tb = wid >> 1, sb = wid & 1;
                    f32x16 p;
#pragma unroll
                    for (int i = 0; i < 16; ++i) p[i] = 0.f;
                    if (!(tb == 0 && sb == 1)) {
#pragma unroll
                        for (int kk = 0; kk < 8; ++kk) {
                            const bf16x8 a = *(const LAS bf16x8*)(lds + L_QS + ((tb * 32 + r) * LDQ + kk * 16 + 8 * hh) * 2);
                            const bf16x8 b = *(const LAS bf16x8*)(lds + L_KS + ((sb * 32 + r) * LDQ + kk * 16 + 8 * hh) * 2);
                            p = MFMA32(a, b, p);
                        }
                    }
                    LAS unsigned short* P = (LAS unsigned short*)(lds + L_P);
#pragma unroll
                    for (int i = 0; i < 16; ++i) { const int row = tb * 32 + rowf(i, hh), col = sb * 32 + r; P[row * LDT + col] = (unsigned short)f2bf(col <= row ? p[i] : 0.f); }
                }
                else {
                const int kb = wid >> 1;
#pragma unroll
                for (int j = 0; j < 2; ++j) {
                    const int vb = 2 * (wid & 1) + j;
#pragma unroll
                    for (int i = 0; i < 16; ++i) S[j][i] *= DV[kb * 32 + rowf(i, hh)];
#pragma unroll
                    for (int kk = 0; kk < 4; ++kk) {
                        const bf16x8 a = *(const LAS bf16x8*)(lds + L_KDT + ((kb * 32 + r) * LDT + kk * 16 + 8 * hh) * 2);
                        const bf16x8 b = *(const LAS bf16x8*)(lds + L_VT + ((vb * 32 + r) * LDT + kk * 16 + 8 * hh) * 2);
                        S[j] = MFMA32(a, b, S[j]);
                    }
                }
            }
                LBAR();
            }
            f32x16 o;
            if (OUT) {
#pragma unroll
                for (int i = 0; i < 16; ++i) o[i] = 0.f;
#pragma unroll
                for (int kk = 0; kk < 8; ++kk) {
                    const bf16x8 a = *(const LAS bf16x8*)(lds + L_QD + ((otb * 32 + r) * LDQ + kk * 16 + 8 * hh) * 2);
                    const bf16x8 b = *(const LAS bf16x8*)(lds + L_ST + ((ovb * 32 + r) * LDQ + kk * 16 + 8 * hh) * 2);
                    o = MFMA32(a, b, o);
                }
#pragma unroll
                for (int kk = 0; kk < 4; ++kk) {
                    const bf16x8 a = *(const LAS bf16x8*)(lds + L_P + ((otb * 32 + r) * LDT + kk * 16 + 8 * hh) * 2);
                    const bf16x8 b = *(const LAS bf16x8*)(lds + L_VT + ((ovb * 32 + r) * LDT + kk * 16 + 8 * hh) * 2);
                    o = MFMA32(a, b, o);
                }
            }
            if (!OUT || wid < 4) {
                const int kb = wid >> 1;
#pragma unroll
                for (int j = 0; j < 2; ++j) {
                    const int vb = 2 * (wid & 1) + j;
#pragma unroll
                    for (int i = 0; i < 16; ++i) S[j][i] *= DV[kb * 32 + rowf(i, hh)];
#pragma unroll
                    for (int kk = 0; kk < 4; ++kk) {
                        const bf16x8 a = *(const LAS bf16x8*)(lds + L_KDT + ((kb * 32 + r) * LDT + kk * 16 + 8 * hh) * 2);
                        const bf16x8 b = *(const LAS bf16x8*)(lds + L_VT + ((vb * 32 + r) * LDT + kk * 16 + 8 * hh) * 2);
                        S[j] = MFMA32(a, b, S[j]);
                    }
                }
            }
            if (OUT) {
                LAS float* STG = (LAS float*)(lds + L_QS);
#pragma unroll
                for (int i = 0; i < 16; ++i) STG[(otb * 32 + rowf(i, hh)) * LDSTG + ovc] = o[i];
                LBAR();
#pragma unroll
                for (int j = 0; j < 2; ++j) {
                    const int tau = ftau + 32 * j;
                    f32x4 a = *(const LAS f32x4*)(STG + tau * LDSTG + fv0), b = *(const LAS f32x4*)(STG + tau * LDSTG + fv0 + 4);
                    if (dir == 0) {
                        st8bf(AOp + (unsigned)((tok0 + tau) * D + h * 128 + fv0), a, b);
                    } else {
                        f32x4 fa, fb, za, zb;
                        { const u32x4 w = aoraw[j];
                          fa[0] = __uint_as_float(w.x << 16); fa[1] = __uint_as_float(w.x & 0xffff0000u); fa[2] = __uint_as_float(w.y << 16); fa[3] = __uint_as_float(w.y & 0xffff0000u);
                          fb[0] = __uint_as_float(w.z << 16); fb[1] = __uint_as_float(w.z & 0xffff0000u); fb[2] = __uint_as_float(w.w << 16); fb[3] = __uint_as_float(w.w & 0xffff0000u); }
                        { const u32x4 w = zgraw[j];
                          za[0] = __uint_as_float(w.x << 16); za[1] = __uint_as_float(w.x & 0xffff0000u); za[2] = __uint_as_float(w.y << 16); za[3] = __uint_as_float(w.y & 0xffff0000u);
                          zb[0] = __uint_as_float(w.z << 16); zb[1] = __uint_as_float(w.z & 0xffff0000u); zb[2] = __uint_as_float(w.w << 16); zb[3] = __uint_as_float(w.w & 0xffff0000u); }
                        a = a + fa; b = b + fb;
                        float ss = (a[0] * a[0] + a[1] * a[1]) + (a[2] * a[2] + a[3] * a[3]) + (b[0] * b[0] + b[1] * b[1]) + (b[2] * b[2] + b[3] * b[3]);
                        ss = row16_sum(ss);
                        const float rstd = rsqrtf(ss * (1.f / 128.f) + EPS);
                        const f32x4 g0 = *(const f32x4*)(hgn_l + h * 128 + fv0), g1 = *(const f32x4*)(hgn_l + h * 128 + fv0 + 4);
                        st8bf(AOp + (unsigned)((tok0 + 63 - tau) * D + h * 128 + fv0), a * rstd * g0 * za, b * rstd * g1 * zb);
                    }
                }
            }
            LBAR();
        }
        if (!OUT) {
            const int r = lane & 31, hh = lane >> 5, kb = wid >> 1;
#pragma unroll
            for (int j = 0; j < 2; ++j) { const int vc = (2 * (wid & 1) + j) * 32 + r;
#pragma unroll
                for (int i = 0; i < 16; ++i) sp[(kb * 32 + rowf(i, hh)) * 128 + vc] = S[j][i]; }
            if (wid == 0) *(f32x2*)(DSEG + ((h * 2 + dir) * NSEG + seg) * 128 + 2 * lane) = (f32x2){__builtin_amdgcn_exp2f(dsa), __builtin_amdgcn_exp2f(dsb)};
        }
    }
}

__device__ __forceinline__ void scan_combine(unsigned char* ws, int tid) {
    float* SEG = (float*)(ws + WS_SEG); const float* DSEG = (const float*)(ws + WS_DSEG);
    const int gt = blockIdx.x * 512 + tid, NGT = gridDim.x * 512;
    for (int e = gt; e < 16 * 16384; e += NGT) {
        const int hd = e >> 14, kv = e & 16383, k = kv >> 7, dir = hd & 1;
        float* base = SEG + (size_t)hd * NSEG * 16384 + kv; const float* db = DSEG + hd * NSEG * 128 + k;
        float tv[NSEG], dv[NSEG];
#pragma unroll
        for (int st = 0; st < NSEG; ++st) { tv[st] = base[(size_t)st * 16384]; dv[st] = db[st * 128]; }
        float s = 0.f;
        if (dir == 0) {
#pragma unroll
            for (int st = 0; st < NSEG; ++st) { base[(size_t)st * 16384] = s; s = dv[st] * s + tv[st]; }
        } else {
#pragma unroll
            for (int st = NSEG - 1; st >= 0; --st) { base[(size_t)st * 16384] = s; s = dv[st] * s + tv[st]; }
        }
    }
}

__device__ __forceinline__ void sgu_item(LAS unsigned char* lds, unsigned char* ws, const float* lng, const float* lnb, const float* sgb, int item, int tid, int wid, int lane) {
    const int cidx = item >> 1, half = item & 1, tok0 = cidx * 128;
    const int r = lane & 31, hh = lane >> 5;
    const bf16* GV = (const bf16*)(ws + WS_GV); const bf16* U = (const bf16*)(ws + WS_U); bf16* BO = (bf16*)(ws + WS_BO); const bf16* SGW = (const bf16*)(ws + WS_SGW);
    constexpr int L_WS = 0, L_VN = 34816, L_MU = 52224, L_RSD = 52736, L_SG = 53248, LDSG = 68;
    LAS float* MU = (LAS float*)(lds + L_MU); LAS float* RSD = (LAS float*)(lds + L_RSD); LAS float* STG = (LAS float*)(lds + L_SG);
    const int e = tid & 63, sp = tid >> 6;
    u32x4 wsreg[4]; unsigned short gvs[16];
    {
        const int g = half * 4;
#pragma unroll
        for (int i = 0; i < 4; ++i) { const int idx = tid + 512 * i; wsreg[i] = *(const u32x4*)(SGW + (size_t)g * 16384 + (idx >> 4) * 128 + (idx & 15) * 8); }
#pragma unroll
        for (int i = 0; i < 16; ++i) gvs[i] = GV[(size_t)(tok0 + sp * 16 + i) * SGWD + g * 64 + e];
    }
    {
        u32x4 graw[16];
#pragma unroll
        for (int i = 0; i < 16; ++i) graw[i] = *(const u32x4*)(GV + (size_t)(tok0 + wid * 16 + i) * SGWD + lane * 8);
#pragma unroll
        for (int i = 0; i < 16; ++i) {
            const int s = wid * 16 + i; f32x4 a, b; { const u32x4 w = graw[i];
                a[0] = __uint_as_float(w.x << 16); a[1] = __uint_as_float(w.x & 0xffff0000u); a[2] = __uint_as_float(w.y << 16); a[3] = __uint_as_float(w.y & 0xffff0000u);
                b[0] = __uint_as_float(w.z << 16); b[1] = __uint_as_float(w.z & 0xffff0000u); b[2] = __uint_as_float(w.w << 16); b[3] = __uint_as_float(w.w & 0xffff0000u); }
            const float mean = wave_sum((a[0] + a[1]) + (a[2] + a[3]) + (b[0] + b[1]) + (b[2] + b[3])) * (1.f / SGWD);
            a = a - mean; b = b - mean;
            const float var = wave_sum((a[0] * a[0] + a[1] * a[1]) + (a[2] * a[2] + a[3] * a[3]) + (b[0] * b[0] + b[1] * b[1]) + (b[2] * b[2] + b[3] * b[3])) * (1.f / SGWD);
            if (lane == 0) { MU[s] = mean; RSD[s] = rsqrtf(var + EPS); }
        }
    }
    LBAR();
    for (int gi = 0; gi < 4; ++gi) {
        const int g = half * 4 + gi;
#pragma unroll
        for (int i = 0; i < 4; ++i) { const int idx = tid + 512 * i; *(LAS u32x4*)(lds + L_WS + ((idx >> 4) * LDQ + (idx & 15) * 8) * 2) = wsreg[i]; }
        {
            const float gg = lng[g * 64 + e], bb = lnb[g * 64 + e];
            unsigned pkd[8];
#pragma unroll
            for (int i = 0; i < 8; ++i) { const int s = sp * 16 + 2 * i;
                pkd[i] = pk2((bf2f(gvs[2 * i]) - MU[s]) * RSD[s] * gg + bb, (bf2f(gvs[2 * i + 1]) - MU[s + 1]) * RSD[s + 1] * gg + bb); }
            LAS u32x4* vp = (LAS u32x4*)(lds + L_VN + (e * LDQ + sp * 16) * 2);
            vp[0] = (u32x4){pkd[0], pkd[1], pkd[2], pkd[3]}; vp[1] = (u32x4){pkd[4], pkd[5], pkd[6], pkd[7]};
        }
        const int et = tid >> 3, eg8 = 8 * (tid & 7);
        u32x4 ureg[2];
#pragma unroll
        for (int j = 0; j < 2; ++j) ureg[j] = *(const u32x4*)(U + (size_t)(tok0 + et + 64 * j) * SGWD + g * 64 + eg8);
        if (gi + 1 < 4) {
#pragma unroll
            for (int i = 0; i < 4; ++i) { const int idx = tid + 512 * i; wsreg[i] = *(const u32x4*)(SGW + (size_t)(g + 1) * 16384 + (idx >> 4) * 128 + (idx & 15) * 8); }
#pragma unroll
            for (int i = 0; i < 16; ++i) gvs[i] = GV[(size_t)(tok0 + sp * 16 + i) * SGWD + (g + 1) * 64 + e];
        }
        LBAR();
        const int tb = wid >> 1, eb = wid & 1;
        f32x16 acc;
#pragma unroll
        for (int i = 0; i < 16; ++i) acc[i] = 0.f;
#pragma unroll
        for (int kk = 0; kk < 8; ++kk) {
            const bf16x8 a = *(const LAS bf16x8*)(lds + L_WS + ((tb * 32 + r) * LDQ + kk * 16 + 8 * hh) * 2);
            const bf16x8 b = *(const LAS bf16x8*)(lds + L_VN + ((eb * 32 + r) * LDQ + kk * 16 + 8 * hh) * 2);
            acc = MFMA32(a, b, acc);
        }
#pragma unroll
        for (int i = 0; i < 16; ++i) STG[(tb * 32 + rowf(i, hh)) * LDSG + eb * 32 + r] = acc[i];
        LBAR();
#pragma unroll
        for (int j = 0; j < 2; ++j) {
            const int t = et + 64 * j; const float bs = sgb[g * 128 + t];
            f32x4 a = *(const LAS f32x4*)(STG + t * LDSG + eg8), b = *(const LAS f32x4*)(STG + t * LDSG + eg8 + 4);
            f32x4 ua, ub; { const u32x4 w = ureg[j];
                ua[0] = __uint_as_float(w.x << 16); ua[1] = __uint_as_float(w.x & 0xffff0000u); ua[2] = __uint_as_float(w.y << 16); ua[3] = __uint_as_float(w.y & 0xffff0000u);
                ub[0] = __uint_as_float(w.z << 16); ub[1] = __uint_as_float(w.z & 0xffff0000u); ub[2] = __uint_as_float(w.w << 16); ub[3] = __uint_as_float(w.w & 0xffff0000u); }
            st8bf(BO + (size_t)(tok0 + t) * SGWD + g * 64 + eg8, (a + bs) * ua, (b + bs) * ub);
        }
        LBAR();
    }
}

#define RLX_AGENT __ATOMIC_RELAXED, __HIP_MEMORY_SCOPE_AGENT
#define XB_TMO      128
#define XB_XCNT(j)  (256  + 64 * (j))
#define XB_XSUB(j)  (1280 + 64 * (j))
#define XB_XGEN(j)  (2304 + 64 * (j))
#define XB_TOP      3328
#define XB_TOPGEN   3392
#define XCD_BAR_WORDS 3456
#define XB_SPIN_CAP (1u << 18)

__device__ __forceinline__ unsigned xb_ld(unsigned* p)              { return __hip_atomic_load(p, __ATOMIC_RELAXED, __HIP_MEMORY_SCOPE_AGENT); }
__device__ __forceinline__ unsigned xb_add(unsigned* p, unsigned v) { return __hip_atomic_fetch_add(p, v, __ATOMIC_RELAXED, __HIP_MEMORY_SCOPE_AGENT); }
__device__ __forceinline__ unsigned xb_xcc_id() { return (unsigned)__builtin_amdgcn_s_getreg((3 << 11) | 20) & 0xFu; }
#define XB_SPIN(cond, bar) do { unsigned _sp = 0; while (cond) { __builtin_amdgcn_s_sleep(1); \
    if ((++_sp & 255u) == 0u) { if (xb_ld(&(bar)[XB_TMO])) break; if (_sp > XB_SPIN_CAP) { atomicAdd(&(bar)[XB_TMO], 1u); break; } } } } while (0)

struct XcdBarrier {
    unsigned* bar; unsigned x;
    volatile LAS unsigned* st;
};

__device__ __forceinline__ XcdBarrier xcd_barrier_post(unsigned* bar, volatile LAS unsigned* st) {
    XcdBarrier b; b.bar = bar; b.x = xb_xcc_id(); b.st = st;
    if (threadIdx.x == 0) (void)xb_add(&bar[XB_XCNT(b.x)], 1u);
    return b;
}
__device__ __forceinline__ void xcd_barrier_complete(unsigned* bar, unsigned x, unsigned& nloc, unsigned& nx) {
    const unsigned G = gridDim.x * gridDim.y * gridDim.z;
    unsigned sum, cnt, mine, sp = 0u;
    for (;;) {
        sum = 0u; cnt = 0u; mine = 0u;
#pragma unroll
        for (unsigned j = 0; j < 16; ++j) { const unsigned c = xb_ld(&bar[XB_XCNT(j)]); sum += c; cnt += (c > 0u) ? 1u : 0u; mine = (j == x) ? c : mine; }
        if (sum == G) break;
        __builtin_amdgcn_s_sleep(1);
        if ((++sp & 255u) == 0u) { if (xb_ld(&bar[XB_TMO])) break; if (sp > XB_SPIN_CAP) { atomicAdd(&bar[XB_TMO], 1u); break; } }
    }
    nloc = mine > 0u ? mine : 1u; nx = cnt > 0u ? cnt : 1u;
}

__device__ __forceinline__ void xcd_barrier(const XcdBarrier& b) {
    asm volatile("s_waitcnt vmcnt(0)" ::: "memory");
    __syncthreads();
    if (threadIdx.x == 0) {
        unsigned* bar = b.bar;
        __builtin_amdgcn_s_waitcnt(0);
        unsigned nloc = b.st[0], nx = b.st[1];
        if (nloc == 0u) { xcd_barrier_complete(bar, b.x, nloc, nx); b.st[0] = nloc; b.st[1] = nx; }
        const unsigned old = xb_add(&bar[XB_XSUB(b.x)], 1u);
        const unsigned gen = old / nloc;
        if (old + 1u == (gen + 1u) * nloc) {
            __builtin_amdgcn_fence(__ATOMIC_RELEASE, "agent");
            asm volatile("s_waitcnt vmcnt(0)" ::: "memory");
            const unsigned og = xb_add(&bar[XB_TOP], 1u);
            const unsigned tg = og / nx;
            if (og + 1u == (tg + 1u) * nx) xb_add(&bar[XB_TOPGEN], 1u);
            else XB_SPIN(xb_ld(&bar[XB_TOPGEN]) == tg, bar);
            __builtin_amdgcn_fence(__ATOMIC_ACQUIRE, "agent");
            xb_add(&bar[XB_XGEN(b.x)], 1u);
            asm volatile("s_waitcnt vmcnt(0)" ::: "memory");
        } else {
            XB_SPIN(xb_ld(&bar[XB_XGEN(b.x)]) == gen, bar);
            __builtin_amdgcn_fence(__ATOMIC_ACQUIRE, "agent");
            asm volatile("s_waitcnt vmcnt(0)" ::: "memory");
        }
    }
    __syncthreads();
}

constexpr size_t WS_BAR = 512 * 1024;
constexpr size_t WS_CNT = 528 * 1024;
constexpr size_t WS_XB = 1280 * 1024;
constexpr size_t CTL_ZERO_BYTES = (528 + 192 - 512) * 1024;
constexpr int LDS_ST = LDS_BYTES - 16;
typedef const __attribute__((address_space(4))) Args* KArgs;
struct RowStat {
    float* xbuf; unsigned* cnt;
    __device__ __forceinline__ void run(const pg8::f32x4 (&v)[2][2][4][2], const pg8::Unit& u, int wr, int wc, int fr, int fq, LAS unsigned char* lds, int wid, int lane) const {
        LAS float* P = (LAS float*)lds;
        LAS float* S = (LAS float*)(lds + 8192);
#pragma unroll
        for (int ai = 0; ai < 2; ++ai)
#pragma unroll
            for (int m = 0; m < 4; ++m) {
                float q = 0.f;
#pragma unroll
                for (int bj = 0; bj < 2; ++bj)
#pragma unroll
                    for (int n = 0; n < 2; ++n) { const pg8::f32x4 x = v[ai][bj][m][n]; q += (x[0] * x[0] + x[1] * x[1]) + (x[2] * x[2] + x[3] * x[3]); }
                q += __shfl_xor(q, 16); q += __shfl_xor(q, 32);
                if (fq == 0) P[(ai * 128 + wr * 64 + m * 16 + fr) * 4 + wc] = q;
            }
        asm volatile("s_waitcnt lgkmcnt(0)" ::: "memory"); __builtin_amdgcn_s_barrier(); asm volatile("" ::: "memory");
        const int row = wid * 32 + (lane & 31);
        if (lane < 32) {
            const float t = (P[row * 4 + 0] + P[row * 4 + 1]) + (P[row * 4 + 2] + P[row * 4 + 3]);
            __hip_atomic_store(xbuf + ((size_t)(u.pm * 256 + row) * 4 + u.pn), t, __ATOMIC_RELAXED, __HIP_MEMORY_SCOPE_AGENT);
        }
        asm volatile("s_waitcnt vmcnt(0)" ::: "memory");
        if (lane == 0) __hip_atomic_fetch_add(cnt + 64 * u.pm, 1u, __ATOMIC_RELAXED, __HIP_MEMORY_SCOPE_AGENT);
        if (wid == 0) {
            unsigned sp = 0;
            while ((unsigned)__builtin_amdgcn_readfirstlane(__hip_atomic_load(cnt + 64 * u.pm, __ATOMIC_RELAXED, __HIP_MEMORY_SCOPE_AGENT)) < 32u) { if (++sp > (1u << 20)) break; __builtin_amdgcn_s_sleep(2); }
            __builtin_amdgcn_fence(__ATOMIC_ACQUIRE, "agent");
        }
        asm volatile("s_waitcnt vmcnt(0) lgkmcnt(0)" ::: "memory"); __builtin_amdgcn_s_barrier(); asm volatile("" ::: "memory");
        if (lane < 32) {
            const float* slot = xbuf + (size_t)(u.pm * 256 + row) * 4; float tot = 0.f;
#pragma unroll
            for (int t = 0; t < 4; ++t) tot += __hip_atomic_load(slot + t, __ATOMIC_RELAXED, __HIP_MEMORY_SCOPE_AGENT);
            S[row] = rsqrtf(tot * (1.f / D) + EPS);
        }
        asm volatile("s_waitcnt lgkmcnt(0)" ::: "memory"); __builtin_amdgcn_s_barrier(); asm volatile("" ::: "memory");
    }
};
struct EpiG4Fused {
    static constexpr bool PERM = true, AFTER_DRAIN = true; static constexpr int MID = 0;
    int l, b;
    __device__ __forceinline__ void fused(pg8::f32x4 (&acc)[2][2][4][2], const pg8::Unit& u, int wr, int wc, int fr, int fq, LAS unsigned char* lds, int wid, int lane) const {
        KArgs ka = (KArgs)__builtin_amdgcn_kernarg_segment_ptr(); asm volatile("" : "+s"(ka));
        unsigned char* ws = ka->ws;
        const float* xin = l == 0 ? ka->in[0] : ka->out; float* xout = ka->out;
        const float* g1 = ka->in[14] + l * D; const float* g2 = ka->in[15] + l * D;
        bf16* H2o = (bf16*)(ws + WS_MIX);
        const int inst = (l * 2 + b) * 2;
        const RowStat st1{(float*)(ws + WS_XB), (unsigned*)(ws + WS_CNT) + (size_t)inst * 4096};
        const RowStat st2{(float*)(ws + WS_XB) + 65536, (unsigned*)(ws + WS_CNT) + (size_t)(inst + 1) * 4096};
        const LAS float* S = (const LAS float*)(lds + 8192);
        const int col0 = u.pn * 256 + wc * 32 + 8 * fq;
        f32x4 pre[4][2][2];
#pragma unroll
        for (int m = 0; m < 4; ++m) { const size_t off = (size_t)(b * TB + u.pm * 256 + wr * 64 + m * 16 + fr) * D + col0;
#pragma unroll
            for (int bj = 0; bj < 2; ++bj)
#pragma unroll
                for (int n = 0; n < 2; ++n) pre[m][bj][n] = *(const f32x4*)(xin + off + bj * 128 + n * 4); }
        st1.run(acc, u, wr, wc, fr, fq, lds, wid, lane);
#pragma unroll
        for (int ai = 0; ai < 2; ++ai)
#pragma unroll
            for (int m = 0; m < 4; ++m) { const int r = ai * 128 + wr * 64 + m * 16 + fr; const float s1 = S[r]; const size_t off = (size_t)(b * TB + u.pm * 256 + r) * D + col0;
#pragma unroll
                for (int bj = 0; bj < 2; ++bj)
#pragma unroll
                    for (int n = 0; n < 2; ++n) { const f32x4 bs = pre[m][bj][n]; const f32x4 gg = *(const f32x4*)(g1 + col0 + bj * 128 + n * 4);
                        acc[ai][bj][m][n] = bs + acc[ai][bj][m][n] * s1 * gg; }
                asm volatile("" : "+v"(acc[ai][0][m][0]), "+v"(acc[ai][0][m][1]), "+v"(acc[ai][1][m][0]), "+v"(acc[ai][1][m][1]));
                if (ai == 0 && m == 3) {
                    asm volatile("" ::: "memory");
#pragma unroll
                    for (int m2 = 0; m2 < 4; ++m2) { const size_t off2 = (size_t)(b * TB + u.pm * 256 + 128 + wr * 64 + m2 * 16 + fr) * D + col0;
#pragma unroll
                        for (int bj = 0; bj < 2; ++bj)
#pragma unroll
                            for (int n = 0; n < 2; ++n) pre[m2][bj][n] = *(const f32x4*)(xin + off2 + bj * 128 + n * 4); }
                } }
        st2.run(acc, u, wr, wc, fr, fq, lds, wid, lane);
#pragma unroll
        for (int ai = 0; ai < 2; ++ai)
#pragma unroll
            for (int m = 0; m < 4; ++m) { const int r = ai * 128 + wr * 64 + m * 16 + fr; const float s2 = S[r]; const size_t off = (size_t)(b * TB + u.pm * 256 + r) * D + col0;
#pragma unroll
                for (int bj = 0; bj < 2; ++bj) { const f32x4 x0 = acc[ai][bj][m][0], x1 = acc[ai][bj][m][1];
                    *(f32x4*)(xout + off + bj * 128) = x0; *(f32x4*)(xout + off + bj * 128 + 4) = x1;
                    const f32x4 h0 = *(const f32x4*)(g2 + col0 + bj * 128), h1 = *(const f32x4*)(g2 + col0 + bj * 128 + 4);
                    st8bf(H2o + off + bj * 128, x0 * s2 * h0, x1 * s2 * h1); }
                asm volatile("" ::: "memory"); }
    }
};
struct EpiG6Fused {
    static constexpr bool PERM = true, AFTER_DRAIN = true; static constexpr int MID = 0;
    int l, b;
    __device__ __forceinline__ void fused(pg8::f32x4 (&acc)[2][2][4][2], const pg8::Unit& u, int wr, int wc, int fr, int fq, LAS unsigned char* lds, int wid, int lane) const {
        KArgs ka = (KArgs)__builtin_amdgcn_kernarg_segment_ptr(); asm volatile("" : "+s"(ka));
        unsigned char* ws = ka->ws;
        float* X = ka->out; const float* g3 = ka->in[19] + l * D;
        bf16* H2o = (bf16*)(ws + WS_H2);
        const RowStat st{(float*)(ws + WS_XB), (unsigned*)(ws + WS_CNT) + (size_t)(8 + l * 2 + b) * 4096};
        const LAS float* S = (const LAS float*)(lds + 8192);
        const int col0 = u.pn * 256 + wc * 32 + 8 * fq;
        f32x4 pre[4][2][2];
#pragma unroll
        for (int m = 0; m < 4; ++m) { const size_t off = (size_t)(b * TB + u.pm * 256 + wr * 64 + m * 16 + fr) * D + col0;
#pragma unroll
            for (int bj = 0; bj < 2; ++bj)
#pragma unroll
                for (int n = 0; n < 2; ++n) pre[m][bj][n] = *(const f32x4*)(X + off + bj * 128 + n * 4); }
        st.run(acc, u, wr, wc, fr, fq, lds, wid, lane);
#pragma unroll
        for (int ai = 0; ai < 2; ++ai)
#pragma unroll
            for (int m = 0; m < 4; ++m) { const int r = ai * 128 + wr * 64 + m * 16 + fr; const float s3 = S[r]; const size_t off = (size_t)(b * TB + u.pm * 256 + r) * D + col0;
#pragma unroll
                for (int bj = 0; bj < 2; ++bj) {
                    const f32x4 b0 = pre[m][bj][0], b1 = pre[m][bj][1];
                    const f32x4 h0 = *(const f32x4*)(g3 + col0 + bj * 128), h1 = *(const f32x4*)(g3 + col0 + bj * 128 + 4);
                    const f32x4 x0 = b0 + acc[ai][bj][m][0] * s3 * h0, x1 = b1 + acc[ai][bj][m][1] * s3 * h1;
                    *(f32x4*)(X + off + bj * 128) = x0; *(f32x4*)(X + off + bj * 128 + 4) = x1;
                    st8bf(H2o + off + bj * 128, x0, x1); }
                if (ai == 0 && m == 3) {
                    asm volatile("" ::: "memory");
#pragma unroll
                    for (int m2 = 0; m2 < 4; ++m2) { const size_t off2 = (size_t)(b * TB + u.pm * 256 + 128 + wr * 64 + m2 * 16 + fr) * D + col0;
#pragma unroll
                        for (int bj = 0; bj < 2; ++bj)
#pragma unroll
                            for (int n = 0; n < 2; ++n) pre[m2][bj][n] = *(const f32x4*)(X + off2 + bj * 128 + n * 4); }
                } }
    }
};
constexpr int PH_PER_LAYER = 18, N_PHASES = 2 * PH_PER_LAYER;
#ifndef PROBE_MASK
#define PROBE_MASK 0
#endif
__global__ void __launch_bounds__(512, 2) mega(Args a) {
    extern __shared__ __attribute__((aligned(16))) unsigned char lds_raw[];
    LAS unsigned char* lds = (LAS unsigned char*)lds_raw;
    if (threadIdx.x < 4) ((LAS unsigned*)(lds + LDS_ST))[threadIdx.x] = 0u;
    __syncthreads();
    (void)xcd_barrier_post((unsigned*)(a.ws + WS_BAR), (volatile LAS unsigned*)(lds + LDS_ST));
    int rep = 0;
    for (int st = a.ph_lo; ; ) {
        int tid = threadIdx.x; asm volatile("" : "+v"(tid));
        KArgs ka = (KArgs)__builtin_amdgcn_kernarg_segment_ptr(); asm volatile("" : "+s"(ka));
        unsigned char* ws = ka->ws; float* X = ka->out;
        int bid = blockIdx.x; asm volatile("" : "+s"(bid));
        const int lane = tid & 63, wave = __builtin_amdgcn_readfirstlane(tid >> 6);
        const int l = st / PH_PER_LAYER, idx = st % PH_PER_LAYER;
        const float* xin = l == 0 ? ka->in[0] : X;
        const bool fusedR1 = (gridDim.x == 256);
        if (fusedR1 && idx == 13) { ++st; continue; }
        const int kind = idx == 0 ? 0 : (idx <= 12 ? 1 + (idx - 1) % 6 : idx - 6);
        if (idx == 0) {
            prologue(ka, ws, l, lds, tid, wave, lane);
            rows_r0(xin, ka->in[2] + l * D, (bf16*)(ws + WS_H), 0, TB, wave, lane);
            if (fusedR1) {
                const float* pr = ka->in[1] + (size_t)l * T * PLE; bf16* pb = (bf16*)(ws + WS_PB2);
                for (size_t i = (size_t)bid * 512 + tid; i < (size_t)T * PLE / 8; i += (size_t)gridDim.x * 512) { const f32x4 a = __builtin_nontemporal_load((const f32x4*)(pr + 8 * i)), b = __builtin_nontemporal_load((const f32x4*)(pr + 8 * i + 4)); st8bf(pb + 8 * i, a, b); }
            }
        } else if (idx <= 12) {
            const int b = (idx - 1) / 6, sub = (idx - 1) % 6;
            if (sub == 0) {
                EpiG1 E{ws, l == 0 ? 1 : 0};
                run_gemm(lds, (const bf16*)(ws + WS_H), (const bf16*)(ws + W_IN), TB, NIN, D, E, tid, bid);
            } else if (sub == 1) {
                for (int it = bid; it < 8 * NSEG; it += gridDim.x) scan_item<false>(lds, ws, ka->in[6] + l * D, it, tid, wave, lane);
                for (int it = bid; it < 128 * 2; it += gridDim.x) sgu_item(lds, ws, ka->in[9] + l * SGWD, ka->in[10] + l * SGWD, ka->in[8] + l * 1024, it, tid, wave, lane);
                if (b == 0) rows_r0(xin, ka->in[2] + l * D, (bf16*)(ws + WS_H), TB, TB, wave, lane);
            } else if (sub == 2) {
                scan_combine(ws, tid);
            } else if (sub == 3) {
                for (int it = bid; it < 8 * NSEG; it += gridDim.x) scan_item<true>(lds, ws, ka->in[6] + l * D, it, tid, wave, lane);
            } else if (sub == 4) {
                { EpiRow8<FG2> E{FG2{ws}};
                  run_gemm(lds, (const bf16*)(ws + WS_AO), (const bf16*)(ws + W_A), TB, D, D, E, tid, bid); }
                { int tid2 = threadIdx.x; asm volatile("" : "+v"(tid2)); KArgs ka2 = (KArgs)__builtin_amdgcn_kernarg_segment_ptr(); asm volatile("" : "+s"(ka2)); unsigned char* ws2 = ka2->ws; int bid2 = blockIdx.x; asm volatile("" : "+s"(bid2));
                  EpiRow8<FG3> E{FG3{ws2}};
                  run_gemm(lds, (const bf16*)(ws2 + WS_BO), (const bf16*)(ws2 + W_B), TB, D, SGWD, E, tid2, bid2); }
            } else if (fusedR1) {
                EpiG4Fused E{l, b};
                run_gemm<EpiG4Fused, false>(lds, (const bf16*)(ws + WS_Q), (const bf16*)(ws + W_O), TB, D, D, E, tid, bid);
            } else {
                EpiRow8<FStore> E{FStore{ws, WS_MIX + (size_t)b * TB * D * 2}};
                run_gemm(lds, (const bf16*)(ws + WS_Q), (const bf16*)(ws + W_O), TB, D, D, E, tid, bid);
            }
        } else if (idx == 13) {
            rows_r12(xin, X, (const bf16*)(ws + WS_MIX), ka->in[14] + l * D, ka->in[15] + l * D, (bf16*)(ws + WS_H2), nullptr, nullptr, wave, lane);
        } else if (idx == 14) {
            EpiSwiglu E{ws};
            run_gemm(lds, (const bf16*)(ws + (fusedR1 ? WS_MIX : WS_H2)), (const bf16*)(ws + W_GU), T, 2 * FF, D, E, tid, bid);
        } else if (fusedR1 && (idx == 15 || idx == 16)) {
            const int b = idx - 15;
            EpiG6Fused E{l, b};
            run_gemm<EpiG6Fused, false>(lds, (const bf16*)(ws + WS_HID) + (size_t)b * TB * FF, (const bf16*)(ws + W_DN), TB, D, FF, E, tid, bid);
        } else if (idx == 15) {
            EpiRow8<FStore> E{FStore{ws, WS_MIX}};
            run_gemm(lds, (const bf16*)(ws + WS_HID), (const bf16*)(ws + W_DN), T, D, FF, E, tid, bid);
        } else if (idx == 16) {
            rows_r12(X, X, (const bf16*)(ws + WS_MIX), ka->in[19] + l * D, nullptr, (bf16*)(ws + WS_H2), ka->in[1] + (size_t)l * T * PLE, (bf16*)(ws + WS_PB), wave, lane);
        } else {
            { EpiRow8<FSig> E{FSig{ws}};
              run_gemm(lds, (const bf16*)(ws + WS_H2), (const bf16*)(ws + W_PG), T, D, D, E, tid, bid); }
            { int tid2 = threadIdx.x; asm volatile("" : "+v"(tid2)); KArgs ka2 = (KArgs)__builtin_amdgcn_kernarg_segment_ptr(); asm volatile("" : "+s"(ka2)); unsigned char* ws2 = ka2->ws; int bid2 = blockIdx.x; asm volatile("" : "+s"(bid2));
              EpiRow8<FG8> E{FG8{ws2, ka2->out}};
              run_gemm(lds, (const bf16*)(ws2 + (gridDim.x == 256 ? WS_PB2 : WS_PB)), (const bf16*)(ws2 + W_PL), T, D, PLE, E, tid2, bid2); }
        }
        if (PROBE_MASK != 0 && rep == 0 && ((PROBE_MASK >> kind) & 1)) { rep = 1; __syncthreads(); continue; }
        rep = 0;
        if (st + 1 >= ka->ph_hi) break;
        if (ka->ph_lo < 0) cg::this_grid().sync();
        else { XcdBarrier xb; xb.bar = (unsigned*)(ka->ws + WS_BAR); xb.x = xb_xcc_id(); xb.st = (volatile LAS unsigned*)(lds + LDS_ST); xcd_barrier(xb); }
        ++st;
    }
}

extern "C" void kernel_launch(void* const* d_in, const int* in_sizes, int n_in, void* d_out, int out_size, void* d_ws, size_t ws_size, hipStream_t stream) {
    static int grid = 0;
    if (grid == 0) {
        if (n_in != 22 || ws_size < WS_END) { fprintf(stderr, "kernel_launch: unexpected n_in %d / ws_size %zu (need %zu)\n", n_in, ws_size, (size_t)WS_END); grid = -1; return; }
        int dev = 0, cus = 0, per_cu = 0;
        hipGetDevice(&dev); hipDeviceGetAttribute(&cus, hipDeviceAttributeMultiprocessorCount, dev);
        hipFuncSetAttribute((const void*)mega, hipFuncAttributeMaxDynamicSharedMemorySize, LDS_BYTES);
        hipOccupancyMaxActiveBlocksPerMultiprocessor(&per_cu, (const void*)mega, 512, LDS_BYTES);
        if (per_cu < 1) per_cu = 1;
        (void)hipGetLastError();
        grid = cus * per_cu;
    }
    if (grid < 0) return;
    if (hipMemsetAsync((char*)d_ws + WS_BAR, 0, CTL_ZERO_BYTES, stream) != hipSuccess) { fprintf(stderr, "memset failed\n"); return; }
    Args a{};
    for (int i = 0; i < 22; ++i) a.in[i] = (const float*)d_in[i];
    a.out = (float*)d_out; a.ws = (unsigned char*)d_ws; a.ph_lo = 0; a.ph_hi = N_PHASES;
    void* args[] = {&a};
    hipError_t e = hipLaunchCooperativeKernel((const void*)mega, dim3(grid), dim3(512), args, LDS_BYTES, stream);
    if (e != hipSuccess) fprintf(stderr, "cooperative launch failed: %s (grid %d)\n", hipGetErrorString(e), grid);
}
```

```cpp
#include <hip/hip_runtime.h>
#include <cstdio>
#include <cstdint>
namespace pg8 {
#define PG8_LAS __attribute__((address_space(3)))
typedef unsigned short bf16_t;
typedef short bf16x8 __attribute__((ext_vector_type(8)));
typedef float f32x4 __attribute__((ext_vector_type(4)));
typedef unsigned u32x4 __attribute__((ext_vector_type(4)));
constexpr int BM = 256, BK = 64, HALF = 128, HTB = HALF * BK * 2  , STAGE_BYTES = 8 * HTB, NXCD = 8, WGM = 4;

__host__ __device__ __forceinline__ int lds_byte(int r, int c) { const int st = (r >> 4) * 2 + (c >> 5), rr = r & 15, cc = c & 31, ob = rr * 64 + cc * 2; return st * 1024 + (ob ^ (((ob >> 9) & 1) << 5)); }
__host__ __device__ __forceinline__ void stage_rc(int b, int& R, int& C) { const int st = b / 1024, sb = b % 1024, swz = sb ^ (((sb >> 9) & 1) << 5); R = (st >> 1) * 16 + swz / 64; C = (st & 1) * 32 + (swz % 64) / 2; }
__host__ __device__ __forceinline__ int perm32(int rho) { const int n = rho >> 4, i = rho & 15; return 8 * (i >> 2) + 4 * n + (i & 3); }

struct Unit { int pm, pn; };
struct Gemm { const bf16_t* A; const bf16_t* Bt; int M, N, K; };

struct StaticOrder {
    int nM, nN, nwg, G, c;
    __host__ __device__ void init(int M, int N, int G_, int c_) { nM = M / BM; nN = N / BM; nwg = nM * nN; G = G_; c = c_; }
    __host__ __device__ bool next(int i, Unit& u) const {
        const long L = (long)i * G + c; if (L >= nwg) return false;
        int wgid = (int)L; { const int q = nwg / NXCD, r = nwg % NXCD, xcd = wgid % NXCD, off = wgid / NXCD; wgid = (xcd < r ? xcd * (q + 1) : r * (q + 1) + (xcd - r) * q) + off; }
        const int nig = WGM * nN, gid = wgid / nig, fm = gid * WGM, gsz = (nM - fm) < WGM ? (nM - fm) : WGM;
        u.pm = fm + ((wgid % nig) % gsz); u.pn = (wgid % nig) / gsz; return true;
    }
    __device__ __forceinline__ void a_ready(const Unit&) const {}
    __device__ __forceinline__ void done(const Unit&) const {}
};

__device__ __forceinline__ unsigned cvt_pk_bf16(float lo, float hi) { unsigned r; asm volatile("v_cvt_pk_bf16_f32 %0, %1, %2" : "=v"(r) : "v"(lo), "v"(hi)); return r; }
template <class Epi, class Sched, bool ALIGN_EPI = false, bool SP2 = false>
__device__ __forceinline__ void gemm_phase(PG8_LAS unsigned char* lds, const Gemm g, const Sched& S, const Epi& E, const int tid) {
    const int wid = __builtin_amdgcn_readfirstlane(tid >> 6), lane = tid & 63, wr = wid >> 2, wc = wid & 3, fr = lane & 15, fq = lane >> 4;
    const int K = g.K, nt = K / BK;
    unsigned voffA[2], voffB[2];
#pragma unroll
    for (int i = 0; i < 2; ++i) { int R, C; stage_rc(tid * 16 + i * 8192, R, C); const int Rb = Epi::PERM ? ((R & ~31) + perm32(R & 31)) : R;
        voffA[i] = (unsigned)(R * K + C) * 2u; voffB[i] = (unsigned)(Rb * K + C) * 2u; }
    const size_t kstep = (size_t)(BK * 2);
    const size_t hstep = (size_t)HALF * K * 2;
    const size_t tstep = 2 * hstep;
    const unsigned ldsw = (unsigned)wid * 1024u;
    const int aoff = lds_byte(wr * 64 + fr, fq * 8), boff = lds_byte(wc * 32 + fr, fq * 8);
#define PG8_SA(b, h) (((b) * 2 + (h)) * HTB)
#define PG8_SB(b, h) ((4 + (b) * 2 + (h)) * HTB)
#define PG8_STAGE(bufoff, gbase, voff) do { _Pragma("unroll") for (int _i = 0; _i < 2; ++_i) \
        __builtin_amdgcn_global_load_lds((const unsigned*)((const char*)(gbase) + (voff)[_i]), (PG8_LAS unsigned*)(lds + (bufoff) + ldsw + _i * 8192), 16, 0, 0); } while (0)
#define PG8_LDA(dst, b, h) do { _Pragma("unroll") for (int m = 0; m < 4; ++m) _Pragma("unroll") for (int k = 0; k < 2; ++k) dst[m][k] = *(const PG8_LAS bf16x8*)(lds + PG8_SA(b, h) + aoff + m * 2048 + k * 1024); } while (0)
#define PG8_LDB(dst, b, h) do { _Pragma("unroll") for (int n = 0; n < 2; ++n) _Pragma("unroll") for (int k = 0; k < 2; ++k) dst[n][k] = *(const PG8_LAS bf16x8*)(lds + PG8_SB(b, h) + boff + n * 2048 + k * 1024); } while (0)
#define PG8_MMA(ai, bj, At, Bt) do { __builtin_amdgcn_s_setprio(1); _Pragma("unroll") for (int m = 0; m < 4; ++m) _Pragma("unroll") for (int n = 0; n < 2; ++n) _Pragma("unroll") for (int k = 0; k < 2; ++k) \
        acc[ai][bj][m][n] = __builtin_amdgcn_mfma_f32_16x16x32_bf16(Bt[n][k], At[m][k], acc[ai][bj][m][n], 0, 0, 0); __builtin_amdgcn_s_setprio(0); } while (0)
#define PG8_WAIT_V(n) asm volatile("s_waitcnt vmcnt(" #n ")" ::: "memory")
#define PG8_WAIT_L(n) asm volatile("s_waitcnt lgkmcnt(" #n ")" ::: "memory")
#define PG8_BAR __builtin_amdgcn_s_barrier()
#define PG8_SCHED __builtin_amdgcn_sched_barrier(0)
    Unit cur, nxt; int ui = 0;
    if (!S.next(0, cur)) return;
    f32x4 acc[2][2][4][2];
#pragma unroll
    for (int a = 0; a < 2; ++a)
#pragma unroll
        for (int b = 0; b < 2; ++b)
#pragma unroll
            for (int m = 0; m < 4; ++m)
#pragma unroll
                for (int n = 0; n < 2; ++n) acc[a][b][m][n] = (f32x4){0.f, 0.f, 0.f, 0.f};
    bf16x8 At[4][2], B0[2][2], B1[2][2];
    const char* cA = (const char*)g.A + (size_t)cur.pm * tstep; const char* cB = (const char*)g.Bt + (size_t)cur.pn * tstep;
    S.a_ready(cur);
    if constexpr (SP2) {
        PG8_STAGE(PG8_SB(0, 0), cB, voffB); PG8_STAGE(PG8_SB(0, 1), cB + hstep, voffB); PG8_STAGE(PG8_SA(0, 0), cA, voffA); PG8_STAGE(PG8_SA(0, 1), cA + hstep, voffA);
        if (wr == 1) PG8_BAR;
        PG8_WAIT_V(2); PG8_BAR;
        PG8_STAGE(PG8_SB(1, 0), cB + kstep, voffB); PG8_STAGE(PG8_SA(1, 0), cA + kstep, voffA); PG8_STAGE(PG8_SB(1, 1), cB + hstep + kstep, voffB);
        PG8_WAIT_V(6); PG8_BAR;
    } else {
        PG8_STAGE(PG8_SB(0, 0), cB, voffB); PG8_STAGE(PG8_SA(0, 0), cA, voffA); PG8_STAGE(PG8_SB(0, 1), cB + hstep, voffB); PG8_STAGE(PG8_SA(0, 1), cA + hstep, voffA);
        if (wr == 1) PG8_BAR;
        PG8_WAIT_V(4); PG8_BAR;
        PG8_STAGE(PG8_SB(1, 0), cB + kstep, voffB); PG8_STAGE(PG8_SA(1, 0), cA + kstep, voffA); PG8_STAGE(PG8_SB(1, 1), cB + hstep + kstep, voffB);
        PG8_WAIT_V(6); PG8_BAR;
    }
    for (;;) {
        const bool has_next = S.next(ui + 1, nxt);
        const char* nA = has_next ? (const char*)g.A + (size_t)nxt.pm * tstep : cA; const char* nB = has_next ? (const char*)g.Bt + (size_t)nxt.pn * tstep : cB;
        for (int t = 0; t < nt; t += 2) {
            const bool last = (t == nt - 2);
            const char* a1 = cA + (size_t)(t + 1) * kstep;
            const char* a2 = last ? nA : cA + (size_t)(t + 2) * kstep; const char* b2 = last ? nB : cB + (size_t)(t + 2) * kstep;
            const char* a3 = a2 + kstep; const char* b3 = b2 + kstep;
            if (last && has_next) S.a_ready(nxt);
            if constexpr (SP2) {
            PG8_LDB(B0, 0, 0); PG8_LDB(B1, 0, 1); PG8_SCHED; PG8_LDA(At, 0, 0); PG8_STAGE(PG8_SA(1, 1), a1 + hstep, voffA);
            PG8_WAIT_V(8); PG8_WAIT_L(0); PG8_BAR; PG8_MMA(0, 0, At, B0); PG8_MMA(0, 1, At, B1); PG8_BAR; PG8_SCHED;
            PG8_LDA(At, 0, 1); PG8_STAGE(PG8_SB(0, 0), b2, voffB); PG8_STAGE(PG8_SB(0, 1), b2 + hstep, voffB); PG8_STAGE(PG8_SA(0, 0), a2, voffA);
            PG8_WAIT_V(8); PG8_WAIT_L(0); PG8_BAR; PG8_MMA(1, 0, At, B0); PG8_MMA(1, 1, At, B1); PG8_BAR; PG8_SCHED;
            PG8_LDB(B0, 1, 0); PG8_LDB(B1, 1, 1); PG8_SCHED; PG8_LDA(At, 1, 0); PG8_STAGE(PG8_SA(0, 1), a2 + hstep, voffA);
            PG8_WAIT_V(8); PG8_WAIT_L(0); PG8_BAR; PG8_MMA(0, 0, At, B0); PG8_MMA(0, 1, At, B1); PG8_BAR; PG8_SCHED;
            PG8_LDA(At, 1, 1); PG8_STAGE(PG8_SB(1, 0), b3, voffB); PG8_STAGE(PG8_SB(1, 1), b3 + hstep, voffB); PG8_STAGE(PG8_SA(1, 0), a3, voffA);
            PG8_WAIT_V(8); PG8_WAIT_L(0); PG8_BAR; PG8_MMA(1, 0, At, B0); PG8_MMA(1, 1, At, B1); PG8_BAR; PG8_SCHED;
            } else {
            PG8_LDB(B0, 0, 0); PG8_SCHED; PG8_LDA(At, 0, 0); PG8_STAGE(PG8_SA(1, 1), a1 + hstep, voffA);
            PG8_WAIT_L(8); PG8_BAR; PG8_WAIT_L(0); PG8_MMA(0, 0, At, B0); PG8_BAR; PG8_SCHED;
            PG8_LDB(B1, 0, 1); PG8_STAGE(PG8_SB(0, 0), b2, voffB);
            PG8_BAR; PG8_WAIT_L(0); PG8_MMA(0, 1, At, B1); PG8_BAR;
            PG8_LDA(At, 0, 1); PG8_STAGE(PG8_SA(0, 0), a2, voffA);
            PG8_BAR; PG8_WAIT_L(0); PG8_MMA(1, 0, At, B0); PG8_BAR; PG8_SCHED;
            PG8_STAGE(PG8_SB(0, 1), b2 + hstep, voffB);
            PG8_WAIT_V(6); PG8_BAR; PG8_MMA(1, 1, At, B1); PG8_BAR;
            PG8_LDB(B0, 1, 0); PG8_SCHED; PG8_LDA(At, 1, 0); PG8_STAGE(PG8_SA(0, 1), a2 + hstep, voffA);
            PG8_WAIT_L(8); PG8_BAR; PG8_WAIT_L(0); PG8_MMA(0, 0, At, B0); PG8_BAR; PG8_SCHED;
            PG8_LDB(B1, 1, 1); PG8_STAGE(PG8_SB(1, 0), b3, voffB);
            PG8_BAR; PG8_WAIT_L(0); PG8_MMA(0, 1, At, B1); PG8_BAR;
            PG8_LDA(At, 1, 1); PG8_STAGE(PG8_SA(1, 0), a3, voffA);
            PG8_BAR; PG8_WAIT_L(0); PG8_MMA(1, 0, At, B0); PG8_BAR; PG8_SCHED;
            PG8_STAGE(PG8_SB(1, 1), b3 + hstep, voffB);
            PG8_WAIT_V(6); PG8_BAR; PG8_MMA(1, 1, At, B1); PG8_BAR;
            }
        }
        if constexpr (ALIGN_EPI) { if (wr == 0) PG8_BAR; }
        if constexpr (!Epi::AFTER_DRAIN) { E(acc, cur, wr, wc, fr, fq); S.done(cur); }
        if (!has_next) break;
#pragma unroll
        for (int a = 0; a < 2; ++a)
#pragma unroll
            for (int b = 0; b < 2; ++b)
#pragma unroll
                for (int m = 0; m < 4; ++m)
#pragma unroll
                    for (int n = 0; n < 2; ++n) acc[a][b][m][n] = (f32x4){0.f, 0.f, 0.f, 0.f};
        cur = nxt; cA = nA; cB = nB; ++ui;
        if constexpr (ALIGN_EPI) { if (wr == 1) PG8_BAR; }
    }
    PG8_WAIT_V(0);
    if constexpr (!ALIGN_EPI) { if (wr == 0) PG8_BAR; }
    PG8_BAR;
    if constexpr (Epi::AFTER_DRAIN) { E.fused(acc, cur, wr, wc, fr, fq, lds, wid, lane); S.done(cur); }
#undef PG8_SA
#undef PG8_SB
#undef PG8_STAGE
#undef PG8_LDA
#undef PG8_LDB
#undef PG8_MMA
#undef PG8_WAIT_V
#undef PG8_WAIT_L
#undef PG8_BAR
#undef PG8_SCHED
}
}

#include <hip/hip_cooperative_groups.h>
namespace cg = cooperative_groups;
#define LAS __attribute__((address_space(3)))
typedef unsigned short bf16;
typedef float f32x4 __attribute__((ext_vector_type(4)));
typedef float f32x16 __attribute__((ext_vector_type(16)));
typedef short bf16x8 __attribute__((ext_vector_type(8)));
typedef unsigned u32x4 __attribute__((ext_vector_type(4)));
typedef unsigned u32x2 __attribute__((ext_vector_type(2)));
typedef float f32x2 __attribute__((ext_vector_type(2)));
#define MFMA32(a, b, c) __builtin_amdgcn_mfma_f32_32x32x16_bf16((a), (b), (c), 0, 0, 0)

constexpr int T = 32768, TB = 16384, D = 1024, NIN = 8192, FF = 2816, PLE = 256, SGWD = 512;
constexpr int NSEG = 32, SEGCH = 8;
constexpr float EPS = 1e-6f;
constexpr size_t MiB = 1u << 20;
constexpr size_t WS_LBT = 0;
constexpr size_t WS_DSEG = 64 * 1024;
constexpr size_t WS_SGW = 1 * MiB;
constexpr size_t WS_W = 2 * MiB;
constexpr size_t W_IN = WS_W, W_A = WS_W + 16 * MiB, W_B = WS_W + 18 * MiB, W_O = WS_W + 19 * MiB, W_GU = WS_W + 21 * MiB,
                 W_DN = WS_W + 32 * MiB, W_PG = WS_W + 32 * MiB + 5632 * 1024, W_PL = W_PG + 2 * MiB;
constexpr size_t WS_H = 42 * MiB;
constexpr size_t WS_MIX = 74 * MiB;
constexpr size_t WS_R = 138 * MiB;
constexpr size_t WS_Q = WS_R, WS_LF = WS_R + 32 * MiB, WS_LB = WS_R + 64 * MiB, WS_V = WS_R + 96 * MiB, WS_ZG = WS_R + 128 * MiB,
                 WS_U = WS_R + 160 * MiB, WS_GV = WS_R + 176 * MiB, WS_SA = WS_R + 192 * MiB, WS_SB = WS_R + 224 * MiB,
                 WS_BO = WS_R + 256 * MiB, WS_AO = WS_R + 272 * MiB, WS_SEG = WS_R + 304 * MiB;
constexpr size_t WS_HID = WS_R, WS_H2 = WS_R + 176 * MiB, WS_PB = WS_R + 240 * MiB;
constexpr size_t WS_PB2 = WS_R + 336 * MiB;
constexpr size_t WS_END = WS_R + 352 * MiB;
static_assert(W_PL + 1024 * 256 * 2 <= WS_H, "weights map");

constexpr int LDS_BYTES = 143360;

__device__ __forceinline__ float bf2f(unsigned b) { return __uint_as_float(b << 16); }
__device__ __forceinline__ unsigned f2bf(float f) { unsigned u = __float_as_uint(f); return (u + 0x7fffu + ((u >> 16) & 1u)) >> 16; }
typedef __bf16 bf16x2_t __attribute__((ext_vector_type(2)));
__device__ __forceinline__ unsigned pk2(float lo, float hi) { f32x2 v = {lo, hi}; bf16x2_t b = __builtin_convertvector(v, bf16x2_t); return __builtin_bit_cast(unsigned, b); }
__device__ __forceinline__ float sigm(float x) { return __builtin_amdgcn_rcpf(1.f + __builtin_amdgcn_exp2f(-1.44269504089f * x)); }
__device__ __forceinline__ float siluf(float x) { return x * sigm(x); }
__device__ __forceinline__ float geluf(float v) {
    const float av = fabsf(v), d = av * 0.2316418882f + 1.0f; const float t = __builtin_amdgcn_rcpf(d);
    float q = t * 0.5307027145f + (-0.7265760135f); q = q * t + 0.7107068705f; q = q * t + (-0.142248368f); q = q * t + 0.127414796f; q = q * t;
    const float e = __builtin_amdgcn_exp2f((v * v) * (-0.72134752044f));
    const float m = v * (q * e); return v < 0.f ? m : v - m; }
__device__ __forceinline__ unsigned f2h(float x) { _Float16 h = (_Float16)x; return (unsigned)__builtin_bit_cast(unsigned short, h); }
__device__ __forceinline__ float h2f(unsigned short b) { return (float)__builtin_bit_cast(_Float16, b); }
__device__ __forceinline__ void st8bf(bf16* p, f32x4 lo, f32x4 hi) {
    u32x4 w; w.x = pk2(lo[0], lo[1]); w.y = pk2(lo[2], lo[3]); w.z = pk2(hi[0], hi[1]); w.w = pk2(hi[2], hi[3]); *(u32x4*)p = w; }
__device__ __forceinline__ void ld8bf(const bf16* p, f32x4& lo, f32x4& hi) {
    const u32x4 w = *(const u32x4*)p;
    lo[0] = __uint_as_float(w.x << 16); lo[1] = __uint_as_float(w.x & 0xffff0000u); lo[2] = __uint_as_float(w.y << 16); lo[3] = __uint_as_float(w.y & 0xffff0000u);
    hi[0] = __uint_as_float(w.z << 16); hi[1] = __uint_as_float(w.z & 0xffff0000u); hi[2] = __uint_as_float(w.w << 16); hi[3] = __uint_as_float(w.w & 0xffff0000u); }
template <int CTRL> __device__ __forceinline__ float dppf(float v) { return __int_as_float(__builtin_amdgcn_update_dpp(0, __float_as_int(v), CTRL, 0xf, 0xf, true)); }
__device__ __forceinline__ float row16_sum(float v) {
    v += dppf<0xB1>(v);
    v += dppf<0x4E>(v);
    v += dppf<0x141>(v);
    v += dppf<0x140>(v);
    return v;
}
__device__ __forceinline__ float wave_sum(float v) {
    v = row16_sum(v);
    v += __shfl_xor(v, 16); v += __shfl_xor(v, 32);
    return v;
}

template <class F> struct EpiRow8 {
    static constexpr bool PERM = true, AFTER_DRAIN = false;
    F f;
    __device__ __forceinline__ void operator()(const pg8::f32x4 (&acc)[2][2][4][2], const pg8::Unit& u, int wr, int wc, int fr, int fq) const {
        { int t_ = threadIdx.x; asm volatile("" : "+v"(t_)); const int w_ = __builtin_amdgcn_readfirstlane(t_ >> 6), l_ = t_ & 63; wr = w_ >> 2; wc = w_ & 3; fr = l_ & 15; fq = l_ >> 4; }
        unsigned char* w = f.ws; asm volatile("" : "+s"(w));
#pragma unroll
        for (int ai = 0; ai < 2; ++ai)
#pragma unroll
            for (int m = 0; m < 4; ++m) {
                const int row = u.pm * 256 + ai * 128 + wr * 64 + m * 16 + fr;
#pragma unroll
                for (int bj = 0; bj < 2; ++bj) {
                    const int col = u.pn * 256 + bj * 128 + wc * 32 + 8 * fq;
                    f(w, row, col, acc[ai][bj][m][0], acc[ai][bj][m][1]);
                }
            }
    }
};
struct EpiSwiglu {
    static constexpr bool PERM = true, AFTER_DRAIN = false;
    unsigned char* ws;
    __device__ __forceinline__ void operator()(const pg8::f32x4 (&acc)[2][2][4][2], const pg8::Unit& u, int wr, int wc, int fr, int fq) const {
        { int t_ = threadIdx.x; asm volatile("" : "+v"(t_)); const int w_ = __builtin_amdgcn_readfirstlane(t_ >> 6), l_ = t_ & 63; wr = w_ >> 2; wc = w_ & 3; fr = l_ & 15; fq = l_ >> 4; }
        unsigned char* w = ws; asm volatile("" : "+s"(w));
        bf16* HID = (bf16*)(w + WS_HID);
#pragma unroll
        for (int ai = 0; ai < 2; ++ai)
#pragma unroll
            for (int m = 0; m < 4; ++m) {
                const int row = u.pm * 256 + ai * 128 + wr * 64 + m * 16 + fr;
                const int hcol = u.pn * 128 + wc * 32 + 8 * fq;
                f32x4 lo, hi;
#pragma unroll
                for (int i = 0; i < 4; ++i) { lo[i] = siluf(acc[ai][0][m][0][i]) * acc[ai][1][m][0][i]; hi[i] = siluf(acc[ai][0][m][1][i]) * acc[ai][1][m][1][i]; }
                st8bf(HID + (size_t)row * FF + hcol, lo, hi);
            }
    }
};

struct EpiG1 {
    static constexpr bool PERM = true, AFTER_DRAIN = false;
    unsigned char* ws; int lb0;
    template <int KIND> __device__ __forceinline__ void seg(unsigned char* w, size_t dst, int ld, int cbase, const float* lb, const pg8::f32x4 (&acc)[2][2][4][2], const pg8::Unit& u, int wr, int wc, int fr, int fq) const {
#pragma unroll
        for (int ai = 0; ai < 2; ++ai)
#pragma unroll
            for (int m = 0; m < 4; ++m) {
                const int row = u.pm * 256 + ai * 128 + wr * 64 + m * 16 + fr;
#pragma unroll
                for (int bj = 0; bj < 2; ++bj) {
                    const int c = u.pn * 256 + bj * 128 + wc * 32 + 8 * fq - cbase;
                    f32x4 lo = acc[ai][bj][m][0], hi = acc[ai][bj][m][1];
                    if (KIND == 4) {
                        const f32x4 l0 = *(const f32x4*)(lb + c), l1 = *(const f32x4*)(lb + c + 4);
                        float r[8];
                        if (lb0) {
#pragma unroll
                            for (int i = 0; i < 4; ++i) {
                                r[i] = fmaxf(-__log2f(1.f + __builtin_amdgcn_exp2f(-1.44269504089f * lo[i])), -126.f);
                                r[4 + i] = fmaxf(-__log2f(1.f + __builtin_amdgcn_exp2f(-1.44269504089f * hi[i])), -126.f);
                            }
                        } else {
#pragma unroll
                        for (int i = 0; i < 4; ++i) {
                            const float f0 = l0[i] + (1.f - l0[i]) * sigm(lo[i]); r[i] = __log2f(fmaxf(f0, 1.17549435e-38f));
                            const float f1 = l1[i] + (1.f - l1[i]) * sigm(hi[i]); r[4 + i] = __log2f(fmaxf(f1, 1.17549435e-38f));
                        }
                        }
                        u32x4 v; v.x = f2h(r[0]) | (f2h(r[1]) << 16); v.y = f2h(r[2]) | (f2h(r[3]) << 16); v.z = f2h(r[4]) | (f2h(r[5]) << 16); v.w = f2h(r[6]) | (f2h(r[7]) << 16);
                        *(u32x4*)((unsigned short*)(w + dst) + (size_t)row * ld + c) = v;
                    } else {
#pragma unroll
                        for (int i = 0; i < 4; ++i) {
                            if (KIND == 1) { lo[i] = siluf(lo[i]); hi[i] = siluf(hi[i]); }
                            if (KIND == 2) { lo[i] = geluf(lo[i]); hi[i] = geluf(hi[i]); }
                            if (KIND == 3) { lo[i] = sigm(lo[i]); hi[i] = sigm(hi[i]); }
                        }
                        st8bf((bf16*)(w + dst) + (size_t)row * ld + c, lo, hi);
                    }
                }
            }
    }
    __device__ __forceinline__ void operator()(const pg8::f32x4 (&acc)[2][2][4][2], const pg8::Unit& u, int wr, int wc, int fr, int fq) const {
        { int t_ = threadIdx.x; asm volatile("" : "+v"(t_)); const int w_ = __builtin_amdgcn_readfirstlane(t_ >> 6), l_ = t_ & 63; wr = w_ >> 2; wc = w_ & 3; fr = l_ & 15; fq = l_ >> 4; }
        unsigned char* w = ws; asm volatile("" : "+s"(w));
        const int sg = u.pn >> 1;
        const float* lbt = (const float*)(w + WS_LBT);
        if (sg < 2) seg<1>(w, WS_Q, D, 0, nullptr, acc, u, wr, wc, fr, fq);
        else if (sg < 4) seg<4>(w, WS_LF, D, 1024, lbt, acc, u, wr, wc, fr, fq);
        else if (sg < 6) seg<4>(w, WS_LB, D, 2048, lbt + 1024, acc, u, wr, wc, fr, fq);
        else if (sg < 8) seg<0>(w, WS_V, D, 3072, nullptr, acc, u, wr, wc, fr, fq);
        else if (sg < 10) seg<1>(w, WS_ZG, D, 4096, nullptr, acc, u, wr, wc, fr, fq);
        else if (sg == 10) seg<2>(w, WS_U, SGWD, 5120, nullptr, acc, u, wr, wc, fr, fq);
        else if (sg == 11) seg<2>(w, WS_GV, SGWD, 5632, nullptr, acc, u, wr, wc, fr, fq);
        else if (sg < 14) seg<3>(w, WS_SA, D, 6144, nullptr, acc, u, wr, wc, fr, fq);
        else seg<3>(w, WS_SB, D, 7168, nullptr, acc, u, wr, wc, fr, fq);
    }
};
struct FG2 { unsigned char* ws;
    __device__ __forceinline__ void operator()(unsigned char* w, int row, int col, f32x4 lo, f32x4 hi) const {
        f32x4 a, b; ld8bf((const bf16*)(w + WS_SA) + (size_t)row * D + col, a, b); st8bf((bf16*)(w + WS_Q) + (size_t)row * D + col, lo * a, hi * b); } };
struct FG3 { unsigned char* ws;
    __device__ __forceinline__ void operator()(unsigned char* w, int row, int col, f32x4 lo, f32x4 hi) const {
        f32x4 a, b, c, d; ld8bf((const bf16*)(w + WS_SB) + (size_t)row * D + col, a, b); bf16* m1 = (bf16*)(w + WS_Q) + (size_t)row * D + col; ld8bf(m1, c, d); st8bf(m1, c + lo * a, d + hi * b); } };
struct FStore { unsigned char* ws; size_t off;
    __device__ __forceinline__ void operator()(unsigned char* w, int row, int col, f32x4 lo, f32x4 hi) const { st8bf((bf16*)(w + off) + (size_t)row * D + col, lo, hi); } };
struct FSig { unsigned char* ws;
    __device__ __forceinline__ void operator()(unsigned char* w, int row, int col, f32x4 lo, f32x4 hi) const {
#pragma unroll
        for (int i = 0; i < 4; ++i) { lo[i] = sigm(lo[i]); hi[i] = sigm(hi[i]); }
        st8bf((bf16*)(w + WS_MIX) + (size_t)row * D + col, lo, hi); } };
struct FG8 { unsigned char* ws; float* X;
    __device__ __forceinline__ void operator()(unsigned char* w, int row, int col, f32x4 lo, f32x4 hi) const {
        f32x4 a, b; ld8bf((const bf16*)(w + WS_MIX) + (size_t)row * D + col, a, b);
        float* xp = X + (size_t)row * D + col; const f32x4 x0 = *(const f32x4*)xp, x1 = *(const f32x4*)(xp + 4);
        *(f32x4*)xp = x0 + lo * a; *(f32x4*)(xp + 4) = x1 + hi * b; } };

template <class Epi, bool ALIGN = true> __device__ __forceinline__ void run_gemm(LAS unsigned char* lds, const bf16* A, const bf16* Bt, int M, int N, int K, const Epi& E, int tid, int bid) {
    pg8::Gemm g{A, Bt, M, N, K}; pg8::StaticOrder S; S.init(M, N, (int)gridDim.x, bid);
    pg8::gemm_phase<Epi, pg8::StaticOrder, ALIGN, true>(lds, g, S, E, tid);
}

__device__ __forceinline__ void transpose_item(const float* W, int K, int N, bf16* WT, int mode, LAS float* scr, int item, int lane) {
    const int nblk = N / 32, kb = item / nblk, nb = item % nblk, k0 = 64 * kb, n0 = 32 * nb;
    const int r0 = mode == 0 ? n0 : (256 * (n0 >> 7) + (n0 & 127) + (mode == 2 ? 128 : 0));
#pragma unroll 8
    for (int i = 0; i < 32; ++i) { const int kk = 2 * i + (lane >> 5); scr[kk * 33 + (lane & 31)] = W[(size_t)(k0 + kk) * N + n0 + (lane & 31)]; }
    asm volatile("s_waitcnt lgkmcnt(0)" ::: "memory");
    const int c = lane & 7;
#pragma unroll
    for (int j = 0; j < 4; ++j) { const int n = (lane >> 3) + 8 * j; const LAS float* s = scr + (8 * c) * 33 + n;
        u32x4 o; o.x = pk2(s[0 * 33], s[1 * 33]); o.y = pk2(s[2 * 33], s[3 * 33]); o.z = pk2(s[4 * 33], s[5 * 33]); o.w = pk2(s[6 * 33], s[7 * 33]);
        *(u32x4*)(WT + (size_t)(r0 + n) * K + k0 + 8 * c) = o; }
    asm volatile("s_waitcnt lgkmcnt(0)" ::: "memory");
}

struct Args { const float* in[22]; float* out; unsigned char* ws; int ph_lo, ph_hi; };

__device__ __forceinline__ void prologue(const __attribute__((address_space(4))) Args* a, unsigned char* ws, int l, LAS unsigned char* lds, int tid, int wave, int lane) {
    LAS float* scr = (LAS float*)(lds + wave * 16384);
    const int gw = blockIdx.x * 8 + wave, NGW = gridDim.x * 8;
    constexpr int I_IN = 16 * 256, I_A = 16 * 32, I_B = 8 * 32, I_O = 16 * 32, I_G = 16 * 88, I_D = 44 * 32, I_PG = 16 * 32, I_PL = 4 * 32;
    constexpr int NIT = I_IN + I_A + I_B + I_O + 2 * I_G + I_D + I_PG + I_PL;
    for (int it = gw; it < NIT; it += NGW) {
        int r = it;
        if (r < I_IN) { transpose_item(a->in[3] + (size_t)l * D * NIN, D, NIN, (bf16*)(ws + W_IN), 0, scr, r, lane); continue; } r -= I_IN;
        if (r < I_A) { transpose_item(a->in[11] + (size_t)l * D * D, D, D, (bf16*)(ws + W_A), 0, scr, r, lane); continue; } r -= I_A;
        if (r < I_B) { transpose_item(a->in[12] + (size_t)l * SGWD * D, SGWD, D, (bf16*)(ws + W_B), 0, scr, r, lane); continue; } r -= I_B;
        if (r < I_O) { transpose_item(a->in[13] + (size_t)l * D * D, D, D, (bf16*)(ws + W_O), 0, scr, r, lane); continue; } r -= I_O;
        if (r < I_G) { transpose_item(a->in[16] + (size_t)l * D * FF, D, FF, (bf16*)(ws + W_GU), 1, scr, r, lane); continue; } r -= I_G;
        if (r < I_G) { transpose_item(a->in[17] + (size_t)l * D * FF, D, FF, (bf16*)(ws + W_GU), 2, scr, r, lane); continue; } r -= I_G;
        if (r < I_D) { transpose_item(a->in[18] + (size_t)l * FF * D, FF, D, (bf16*)(ws + W_DN), 0, scr, r, lane); continue; } r -= I_D;
        if (r < I_PG) { transpose_item(a->in[21] + (size_t)l * D * D, D, D, (bf16*)(ws + W_PG), 0, scr, r, lane); continue; } r -= I_PG;
        transpose_item(a->in[20] + (size_t)l * PLE * D, PLE, D, (bf16*)(ws + W_PL), 0, scr, r, lane);
    }
    const int gt = blockIdx.x * 512 + tid, NGT = gridDim.x * 512;
    for (int i = gt; i < 2048; i += NGT) {
        const float* gm = a->in[i < 1024 ? 4 : 5]; const int c = i & 1023;
        ((float*)(ws + WS_LBT))[i] = (l == 0) ? 0.f : 1.f / (1.f + __expf(gm[c] - gm[1024 + c]));
    }
    for (int i = gt; i < 8 * 128 * 128 / 2; i += NGT) {
        const float* s = a->in[7] + (size_t)l * 131072 + 2 * i;
        ((unsigned*)(ws + WS_SGW))[i] = pk2(s[0], s[1]);
    }
}

__device__ __forceinline__ void ldrow8(const float* p, f32x4& a, f32x4& b) { a = *(const f32x4*)p; b = *(const f32x4*)(p + 4); }
__device__ __forceinline__ float sq8(const f32x4& a, const f32x4& b) { return (a[0] * a[0] + a[1] * a[1]) + (a[2] * a[2] + a[3] * a[3]) + (b[0] * b[0] + b[1] * b[1]) + (b[2] * b[2] + b[3] * b[3]); }
__device__ __forceinline__ void rows_r0(const float* xin, const float* g, bf16* H, int row0, int nrows, int wave, int lane) {
    const int gw = blockIdx.x * 8 + wave, NGW = gridDim.x * 8;
    f32x4 ga[2], gb[2];
#pragma unroll
    for (int j = 0; j < 2; ++j) ldrow8(g + 8 * lane + 512 * j, ga[j], gb[j]);
    for (int m = gw; m < nrows; m += NGW) {
        const float* xr = xin + (size_t)(row0 + m) * D + 8 * lane; f32x4 va[2], vb[2]; float s = 0.f;
#pragma unroll
        for (int j = 0; j < 2; ++j) { ldrow8(xr + 512 * j, va[j], vb[j]); s += sq8(va[j], vb[j]); }
        const float r = rsqrtf(wave_sum(s) * (1.f / D) + EPS);
        bf16* o = H + (size_t)m * D + 8 * lane;
#pragma unroll
        for (int j = 0; j < 2; ++j) st8bf(o + 512 * j, va[j] * r * ga[j], vb[j] * r * gb[j]);
    }
}
__device__ __forceinline__ void rows_r12(const float* xin, float* xout, const bf16* Y, const float* g1, const float* g2, bf16* Hout, const float* prow, bf16* PB, int wave, int lane) {
    const int gw = blockIdx.x * 8 + wave, NGW = gridDim.x * 8;
    for (int m = gw; m < T; m += NGW) {
        const float* xr = xin + (size_t)m * D + 8 * lane; const bf16* yr = Y + (size_t)m * D + 8 * lane;
        f32x4 va[2], vb[2], ya[2], yb[2]; float s = 0.f;
#pragma unroll
        for (int j = 0; j < 2; ++j) { ldrow8(xr + 512 * j, va[j], vb[j]); ld8bf(yr + 512 * j, ya[j], yb[j]); s += sq8(ya[j], yb[j]); }
        f32x4 pv; if (prow) pv = *(const f32x4*)(prow + (size_t)m * PLE + 4 * lane);
        const float r = rsqrtf(wave_sum(s) * (1.f / D) + EPS);
        float s2 = 0.f;
#pragma unroll
        for (int j = 0; j < 2; ++j) { f32x4 ga, gb; ldrow8(g1 + 8 * lane + 512 * j, ga, gb); va[j] = va[j] + ya[j] * r * ga; vb[j] = vb[j] + yb[j] * r * gb;
            float* xo = xout + (size_t)m * D + 8 * lane + 512 * j; *(f32x4*)xo = va[j]; *(f32x4*)(xo + 4) = vb[j];
            s2 += sq8(va[j], vb[j]); }
        bf16* o = Hout + (size_t)m * D + 8 * lane;
        if (g2) {
            const float r2 = rsqrtf(wave_sum(s2) * (1.f / D) + EPS);
#pragma unroll
            for (int j = 0; j < 2; ++j) { f32x4 ga, gb; ldrow8(g2 + 8 * lane + 512 * j, ga, gb); st8bf(o + 512 * j, va[j] * r2 * ga, vb[j] * r2 * gb); }
        } else {
#pragma unroll
            for (int j = 0; j < 2; ++j) st8bf(o + 512 * j, va[j], vb[j]);
        }
        if (prow) { u32x2 w; w.x = pk2(pv[0], pv[1]); w.y = pk2(pv[2], pv[3]); *(u32x2*)(PB + (size_t)m * PLE + 4 * lane) = w; }
    }
}

constexpr int LDQ = 136, LDT = 72, LDSTG = 132;
constexpr int L_QD = 0, L_QS = 17408, L_KS = 34816, L_KDT = 52224, L_VT = 70656, L_ST = 89088, L_P = 123904, L_TOT = 133120, L_DV = 137216, L_RS = 137728;
static_assert(L_RS + 1024 <= LDS_BYTES - 16 && 64 * LDSTG * 4 <= L_KDT - L_QS, "lds map");
__device__ __forceinline__ int rowf(int reg, int hh) { return (reg & 3) + 8 * (reg >> 2) + 4 * hh; }

#define LBAR() asm volatile("s_waitcnt lgkmcnt(0)\n\ts_barrier" ::: "memory")
template <bool OUT>
__device__ __forceinline__ void scan_item(LAS unsigned char* lds, unsigned char* ws, const float* hgn_l, int item, int tid_in, int wid, int lane_in) {
    const int h = item / NSEG, seg = item % NSEG;
    float* SEG = (float*)(ws + WS_SEG); float* DSEG = (float*)(ws + WS_DSEG);
    const bf16* Qp = (const bf16*)(ws + WS_Q); const bf16* Vp = (const bf16*)(ws + WS_V); bf16* AOp = (bf16*)(ws + WS_AO); const bf16* ZGp = (const bf16*)(ws + WS_ZG);
    LAS unsigned short* QD = (LAS unsigned short*)(lds + L_QD); LAS unsigned short* QS = (LAS unsigned short*)(lds + L_QS); LAS unsigned short* KS = (LAS unsigned short*)(lds + L_KS);
    LAS float* TOT = (LAS float*)(lds + L_TOT); LAS float* DV = (LAS float*)(lds + L_DV); LAS float* RS = (LAS float*)(lds + L_RS);
    for (int dir = 0; dir < 2; ++dir) {
        if (OUT && dir == 1) __syncthreads();
        int tid = tid_in, lane = lane_in;
        asm volatile("" : "+v"(tid), "+v"(lane));
        f32x16 S[2];
        float* sp = SEG + (size_t)((h * 2 + dir) * NSEG + seg) * 16384;
        {
            const int r = lane & 31, hh = lane >> 5, kb = wid >> 1;
#pragma unroll
            for (int j = 0; j < 2; ++j) { const int vc = (2 * (wid & 1) + j) * 32 + r;
#pragma unroll
                for (int i = 0; i < 16; ++i) S[j][i] = OUT ? sp[(kb * 32 + rowf(i, hh)) * 128 + vc] : 0.f; }
        }
        const unsigned short* LFp = (const unsigned short*)(ws + (dir ? WS_LB : WS_LF));
        unsigned lraw[8], vraw[8], qraw[8];
        float dsa = 0.f, dsb = 0.f;
        const int es = dir ? -D : D;
        {
            const int c = seg * SEGCH + (dir ? SEGCH - 1 : 0);
            const unsigned e0 = (unsigned)((c * 64 + (dir ? 63 - wid * 8 : wid * 8)) * D + h * 128 + 2 * lane);
#pragma unroll
            for (int i = 0; i < 8; ++i) lraw[i] = *(const unsigned*)(LFp + (e0 + (unsigned)(i * es)));
#pragma unroll
            for (int i = 0; i < 8; ++i) vraw[i] = *(const unsigned*)(Vp + (e0 + (unsigned)(i * es)));
            if (OUT) {
#pragma unroll
                for (int i = 0; i < 8; ++i) qraw[i] = *(const unsigned*)(Qp + (e0 + (unsigned)(i * es)));
            }
        }
        for (int ci = 0; ci < SEGCH; ++ci) {
            asm volatile("" : "+v"(tid), "+v"(lane));
            const int r = lane & 31, hh = lane >> 5;
            const int c = seg * SEGCH + (dir ? SEGCH - 1 - ci : ci), tok0 = c * 64;
            if (OUT) {
                const int kb = wid >> 1;
#pragma unroll
                for (int j = 0; j < 2; ++j) { const int vcol = (2 * (wid & 1) + j) * 32 + r;
#pragma unroll
                    for (int g = 0; g < 4; ++g) { u32x2 w; w.x = pk2(S[j][4 * g], S[j][4 * g + 1]); w.y = pk2(S[j][4 * g + 2], S[j][4 * g + 3]);
                        *(LAS u32x2*)(lds + L_ST + (vcol * LDQ + kb * 32 + 8 * g + 4 * hh) * 2) = w; } }
            }
            float bla[8], blb[8], lfa[8], lfb[8]; float runa = 0.f, runb = 0.f;
#pragma unroll
            for (int i = 0; i < 8; ++i) { lfa[i] = h2f((unsigned short)(lraw[i] & 0xffffu)); lfb[i] = h2f((unsigned short)(lraw[i] >> 16)); runa += lfa[i]; runb += lfb[i]; bla[i] = runa; blb[i] = runb; }
            *(LAS f32x2*)(TOT + wid * 128 + 2 * lane) = (f32x2){runa, runb};
            LBAR();
            float offa = 0.f, offb = 0.f, bma = 0.f, bmb = 0.f, bta = 0.f, btb = 0.f;
#pragma unroll
            for (int p = 0; p < 8; ++p) { const f32x2 t = *(const LAS f32x2*)(TOT + p * 128 + 2 * lane);
                if (p < wid) { offa += t[0]; offb += t[1]; } if (p < 4) { bma += t[0]; bmb += t[1]; } bta += t[0]; btb += t[1]; }
            const float c1a = __builtin_amdgcn_exp2f(bta - bma), c1b = __builtin_amdgcn_exp2f(btb - bmb), c2a = __builtin_amdgcn_exp2f(bma), c2b = __builtin_amdgcn_exp2f(bmb);
            float kda[8], kdb[8];
#pragma unroll
            for (int i = 0; i < 8; ++i) {
                const float ba = bla[i] + offa, bb = blb[i] + offb;
                const float kka = 1.f - __builtin_amdgcn_exp2f(lfa[i]), kkb = 1.f - __builtin_amdgcn_exp2f(lfb[i]);
                if (OUT) {
                    const int tau = wid * 8 + i;
                    const float qa = __uint_as_float(qraw[i] << 16), qb = __uint_as_float(qraw[i] & 0xffff0000u);
                    const float qsa = qa * __builtin_amdgcn_exp2f(fminf(ba - bma, 115.f)), qsb = qb * __builtin_amdgcn_exp2f(fminf(bb - bmb, 115.f));
                    const float ksa = kka * __builtin_amdgcn_exp2f(fminf(bma - ba, 115.f)), ksb = kkb * __builtin_amdgcn_exp2f(fminf(bmb - bb, 115.f));
                    kda[i] = ksa * c1a; kdb[i] = ksb * c1b;
                    *(LAS unsigned*)(lds + L_QD + (tau * LDQ + 2 * lane) * 2) = pk2(qsa * c2a, qsb * c2b);
                    *(LAS unsigned*)(lds + L_QS + (tau * LDQ + 2 * lane) * 2) = pk2(qsa, qsb);
                    *(LAS unsigned*)(lds + L_KS + (tau * LDQ + 2 * lane) * 2) = pk2(ksa, ksb);
                } else {
                    kda[i] = kka * __builtin_amdgcn_exp2f(bta - ba); kdb[i] = kkb * __builtin_amdgcn_exp2f(btb - bb);
                }
            }
            {
                LAS u32x4* kp = (LAS u32x4*)(lds + L_KDT + ((2 * lane) * LDT + wid * 8) * 2); LAS u32x4* vp = (LAS u32x4*)(lds + L_VT + ((2 * lane) * LDT + wid * 8) * 2);
                kp[0] = (u32x4){pk2(kda[0], kda[1]), pk2(kda[2], kda[3]), pk2(kda[4], kda[5]), pk2(kda[6], kda[7])};
                kp[LDT * 2 / 16] = (u32x4){pk2(kdb[0], kdb[1]), pk2(kdb[2], kdb[3]), pk2(kdb[4], kdb[5]), pk2(kdb[6], kdb[7])};
                u32x4 va, vb;
#pragma unroll
                for (int j = 0; j < 4; ++j) { va[j] = (vraw[2 * j] & 0xffffu) | (vraw[2 * j + 1] << 16); vb[j] = (vraw[2 * j] >> 16) | (vraw[2 * j + 1] & 0xffff0000u); }
                vp[0] = va; vp[LDT * 2 / 16] = vb;
            }
            if (wid == 0) { *(LAS f32x2*)(DV + 2 * lane) = (f32x2){__builtin_amdgcn_exp2f(bta), __builtin_amdgcn_exp2f(btb)}; dsa += bta; dsb += btb; }
            if (ci + 1 < SEGCH) {
                const int cn = seg * SEGCH + (dir ? SEGCH - 2 - ci : ci + 1);
                const unsigned e0 = (unsigned)((cn * 64 + (dir ? 63 - wid * 8 : wid * 8)) * D + h * 128 + 2 * lane);
#pragma unroll
                for (int i = 0; i < 8; ++i) lraw[i] = *(const unsigned*)(LFp + (e0 + (unsigned)(i * es)));
#pragma unroll
                for (int i = 0; i < 8; ++i) vraw[i] = *(const unsigned*)(Vp + (e0 + (unsigned)(i * es)));
                if (OUT) {
#pragma unroll
                    for (int i = 0; i < 8; ++i) qraw[i] = *(const unsigned*)(Qp + (e0 + (unsigned)(i * es)));
                }
            }
            u32x4 aoraw[2], zgraw[2];
            const int otb = wid >> 2, ovb = wid & 3, ovc = ovb * 32 + r;
            const int ftau = tid >> 4, fv0 = 8 * (tid & 15);
            if (OUT && dir == 1) {
#pragma unroll
                for (int j = 0; j < 2; ++j) { const unsigned ad = (unsigned)((tok0 + 63 - (ftau + 32 * j)) * D + h * 128 + fv0); aoraw[j] = *(const u32x4*)(AOp + ad); zgraw[j] = *(const u32x4*)(ZGp + ad); }
            }
            LBAR();
            if (OUT) {
                if (wid < 4) {
                    const int tb = wid >> 1, sb = wid & 1;
                    f32x16 p;
#pragma unroll
                    for (int i = 0; i < 16; ++i) p[i] = 0.f;
                    if (!(tb == 0 && sb == 1)) {
#pragma unroll
                        for (int kk = 0; kk < 8; ++kk) {
                            const bf16x8 a = *(const LAS bf16x8*)(lds + L_QS + ((tb * 32 + r) * LDQ + kk * 16 + 8 * hh) * 2);
                            const bf16x8 b = *(const LAS bf16x8*)(lds + L_KS + ((sb * 32 + r) * LDQ + kk * 16 + 8 * hh) * 2);
                            p = MFMA32(a, b, p);
                        }
                    }
                    LAS unsigned short* P = (LAS unsigned short*)(lds + L_P);
#pragma unroll
                    for (int i = 0; i < 16; ++i) { const int row = tb * 32 + rowf(i, hh), col = sb * 32 + r; P[row * LDT + col] = (unsigned short)f2bf(col <= row ? p[i] : 0.f); }
                }
                else {
                const int kb = wid >> 1;
#pragma unroll
                for (int j = 0; j < 2; ++j) {
                    const int vb = 2 * (wid & 1) + j;
#pragma unroll
                    for (int i = 0; i < 16; ++i) S[j][i] *= DV[kb * 32 + rowf(i, hh)];
#pragma unroll
                    for (int kk = 0; kk < 4; ++kk) {
                        const bf16x8 a = *(const LAS bf16x8*)(lds + L_KDT + ((kb * 32 + r) * LDT + kk * 16 + 8 * hh) * 2);
                        const bf16x8 b = *(const LAS bf16x8*)(lds + L_VT + ((vb * 32 + r) * LDT + kk * 16 + 8 * hh) * 2);
                        S[j] = MFMA32(a, b, S[j]);
                    }
                }
            }
                LBAR();
            }
            f32x16 o;
            if (OUT) {
#pragma unroll
                for (int i = 0; i < 16; ++i) o[i] = 0.f;
#pragma unroll
                for (int kk = 0; kk < 8; ++kk) {
                    const bf16x8 a = *(const LAS bf16x8*)(lds + L_QD + ((otb * 32 + r) * LDQ + kk * 16 + 8 * hh) * 2);
                    const bf16x8 b = *(const LAS bf16x8*)(lds + L_ST + ((ovb * 32 + r) * LDQ + kk * 16 + 8 * hh) * 2);
                    o = MFMA32(a, b, o);
                }
#pragma unroll
                for (int kk = 0; kk < 4; ++kk) {
                    const bf16x8 a = *(const LAS bf16x8*)(lds + L_P + ((otb * 32 + r) * LDT + kk * 16 + 8 * hh) * 2);
                    const bf16x8 b = *(const LAS bf16x8*)(lds + L_VT + ((ovb * 32 + r) * LDT + kk * 16 + 8 * hh) * 2);
                    o = MFMA32(a, b, o);
                }
            }
            if (!OUT || wid < 4) {
                const int kb = wid >> 1;
#pragma unroll
                for (int j = 0; j < 2; ++j) {
                    const int vb = 2 * (wid & 1) + j;
#pragma unroll
                    for (int i = 0; i < 16; ++i) S[j][i] *= DV[kb * 32 + rowf(i, hh)];
#pragma unroll
                    for (int kk = 0; kk < 4; ++kk) {
                        const bf16x8 a = *(const LAS bf16x8*)(lds + L_KDT + ((kb * 32 + r) * LDT + kk * 16 + 8 * hh) * 2);
                        const bf16x8 b = *(const LAS bf16x8*)(lds + L_VT + ((vb * 32 + r) * LDT + kk * 16 + 8 * hh) * 2);
                        S[j] = MFMA32(a, b, S[j]);
                    }
                }
            }
            if (OUT) {
                LAS float* STG = (LAS float*)(lds + L_QS);
#pragma unroll
                for (int i = 0; i < 16; ++i) STG[(otb * 32 + rowf(i, hh)) * LDSTG + ovc] = o[i];
                LBAR();
#pragma unroll
                for (int j = 0; j < 2; ++j) {
                    const int tau = ftau + 32 * j;
                    f32x4 a = *(const LAS f32x4*)(STG + tau * LDSTG + fv0), b = *(const LAS f32x4*)(STG + tau * LDSTG + fv0 + 4);
                    if (dir == 0) {
                        st8bf(AOp + (unsigned)((tok0 + tau) * D + h * 128 + fv0), a, b);
                    } else {
                        f32x4 fa, fb, za, zb;
                        { const u32x4 w = aoraw[j];
                          fa[0] = __uint_as_float(w.x << 16); fa[1] = __uint_as_float(w.x & 0xffff0000u); fa[2] = __uint_as_float(w.y << 16); fa[3] = __uint_as_float(w.y & 0xffff0000u);
                          fb[0] = __uint_as_float(w.z << 16); fb[1] = __uint_as_float(w.z & 0xffff0000u); fb[2] = __uint_as_float(w.w << 16); fb[3] = __uint_as_float(w.w & 0xffff0000u); }
                        { const u32x4 w = zgraw[j];
                          za[0] = __uint_as_float(w.x << 16); za[1] = __uint_as_float(w.x & 0xffff0000u); za[2] = __uint_as_float(w.y << 16); za[3] = __uint_as_float(w.y & 0xffff0000u);
                          zb[0] = __uint_as_float(w.z << 16); zb[1] = __uint_as_float(w.z & 0xffff0000u); zb[2] = __uint_as_float(w.w << 16); zb[3] = __uint_as_float(w.w & 0xffff0000u); }
                        a = a + fa; b = b + fb;
                        float ss = (a[0] * a[0] + a[1] * a[1]) + (a[2] * a[2] + a[3] * a[3]) + (b[0] * b[0] + b[1] * b[1]) + (b[2] * b[2] + b[3] * b[3]);
                        ss = row16_sum(ss);
                        const float rstd = rsqrtf(ss * (1.f / 128.f) + EPS);
                        const f32x4 g0 = *(const f32x4*)(hgn_l + h * 128 + fv0), g1 = *(const f32x4*)(hgn_l + h * 128 + fv0 + 4);
                        st8bf(AOp + (unsigned)((tok0 + 63 - tau) * D + h * 128 + fv0), a * rstd * g0 * za, b * rstd * g1 * zb);
                    }
                }
            }
            LBAR();
        }
        if (!OUT) {
            const int r = lane & 31, hh = lane >> 5, kb = wid >> 1;
#pragma unroll
            for (int j = 0; j < 2; ++j) { const int vc = (2 * (wid & 1) + j) * 32 + r;
#pragma unroll
                for (int i = 0; i < 16; ++i) sp[(kb * 32 + rowf(i, hh)) * 128 + vc] = S[j][i]; }
            if (wid == 0) *(f32x2*)(DSEG + ((h * 2 + dir) * NSEG + seg) * 128 + 2 * lane) = (f32x2){__builtin_amdgcn_exp2f(dsa), __builtin_amdgcn_exp2f(dsb)};
        }
    }
}

__device__ __forceinline__ void scan_p1_item(LAS unsigned char* lds, unsigned char* ws, int item, int tid_in, int wid, int lane_in) {
    const int h = item / NSEG, seg = item % NSEG;
    float* SEG = (float*)(ws + WS_SEG); float* DSEG = (float*)(ws + WS_DSEG);
    const unsigned short* LFp = (const unsigned short*)(ws + WS_LF); const unsigned short* LBp = (const unsigned short*)(ws + WS_LB); const bf16* Vp = (const bf16*)(ws + WS_V);
    constexpr int P_KF = 0, P_KB = 18432, P_VT = 36864, P_TOT = 55296, P_DV = 63488;
    LAS float* TOT = (LAS float*)(lds + P_TOT); LAS float* DV = (LAS float*)(lds + P_DV);
    int tid = tid_in, lane = lane_in;
    asm volatile("" : "+v"(tid), "+v"(lane));
    f32x16 Sf[2], Sb[2];
#pragma unroll
    for (int j = 0; j < 2; ++j)
#pragma unroll
        for (int i = 0; i < 16; ++i) { Sf[j][i] = 0.f; Sb[j][i] = 0.f; }
    float dsfa = 0.f, dsfb = 0.f, pba = 0.f, pbb = 0.f;
    unsigned lraw[8], braw[8], vraw[8];
    {
        const unsigned e0 = (unsigned)(((seg * SEGCH) * 64 + wid * 8) * D + h * 128 + 2 * lane);
#pragma unroll
        for (int i = 0; i < 8; ++i) lraw[i] = *(const unsigned*)(LFp + (e0 + (unsigned)(i * D)));
#pragma unroll
        for (int i = 0; i < 8; ++i) braw[i] = *(const unsigned*)(LBp + (e0 + (unsigned)(i * D)));
#pragma unroll
        for (int i = 0; i < 8; ++i) vraw[i] = *(const unsigned*)(Vp + (e0 + (unsigned)(i * D)));
    }
    for (int ci = 0; ci < SEGCH; ++ci) {
        asm volatile("" : "+v"(tid), "+v"(lane));
        const int r = lane & 31, hh = lane >> 5;
        float blfa[8], blfb[8], lfa[8], lfb[8], blba[8], blbb[8], lba[8], lbb[8]; float rfa = 0.f, rfb = 0.f, rba = 0.f, rbb = 0.f;
#pragma unroll
        for (int i = 0; i < 8; ++i) {
            lfa[i] = h2f((unsigned short)(lraw[i] & 0xffffu)); lfb[i] = h2f((unsigned short)(lraw[i] >> 16)); rfa += lfa[i]; rfb += lfb[i]; blfa[i] = rfa; blfb[i] = rfb;
            lba[i] = h2f((unsigned short)(braw[i] & 0xffffu)); lbb[i] = h2f((unsigned short)(braw[i] >> 16)); blba[i] = rba; blbb[i] = rbb; rba += lba[i]; rbb += lbb[i];
        }
        *(LAS f32x2*)(TOT + wid * 128 + 2 * lane) = (f32x2){rfa, rfb};
        *(LAS f32x2*)(TOT + (8 + wid) * 128 + 2 * lane) = (f32x2){rba, rbb};
        LBAR();
        float offa = 0.f, offb = 0.f, bta = 0.f, btb = 0.f, oba = 0.f, obb = 0.f, tba = 0.f, tbb = 0.f;
#pragma unroll
        for (int p = 0; p < 8; ++p) { const f32x2 t = *(const LAS f32x2*)(TOT + p * 128 + 2 * lane), u = *(const LAS f32x2*)(TOT + (8 + p) * 128 + 2 * lane);
            if (p < wid) { offa += t[0]; offb += t[1]; oba += u[0]; obb += u[1]; } bta += t[0]; btb += t[1]; tba += u[0]; tbb += u[1]; }
        float kfa[8], kfb[8], kba[8], kbb[8];
#pragma unroll
        for (int i = 0; i < 8; ++i) {
            kfa[i] = (1.f - __builtin_amdgcn_exp2f(lfa[i])) * __builtin_amdgcn_exp2f(bta - (blfa[i] + offa));
            kfb[i] = (1.f - __builtin_amdgcn_exp2f(lfb[i])) * __builtin_amdgcn_exp2f(btb - (blfb[i] + offb));
            kba[i] = (1.f - __builtin_amdgcn_exp2f(lba[i])) * __builtin_amdgcn_exp2f(pba + oba + blba[i]);
            kbb[i] = (1.f - __builtin_amdgcn_exp2f(lbb[i])) * __builtin_amdgcn_exp2f(pbb + obb + blbb[i]);
        }
        {
            LAS u32x4* kf = (LAS u32x4*)(lds + P_KF + ((2 * lane) * LDT + wid * 8) * 2); LAS u32x4* kb_ = (LAS u32x4*)(lds + P_KB + ((2 * lane) * LDT + wid * 8) * 2); LAS u32x4* vp = (LAS u32x4*)(lds + P_VT + ((2 * lane) * LDT + wid * 8) * 2);
            kf[0] = (u32x4){pk2(kfa[0], kfa[1]), pk2(kfa[2], kfa[3]), pk2(kfa[4], kfa[5]), pk2(kfa[6], kfa[7])};
            kf[LDT * 2 / 16] = (u32x4){pk2(kfb[0], kfb[1]), pk2(kfb[2], kfb[3]), pk2(kfb[4], kfb[5]), pk2(kfb[6], kfb[7])};
            kb_[0] = (u32x4){pk2(kba[0], kba[1]), pk2(kba[2], kba[3]), pk2(kba[4], kba[5]), pk2(kba[6], kba[7])};
            kb_[LDT * 2 / 16] = (u32x4){pk2(kbb[0], kbb[1]), pk2(kbb[2], kbb[3]), pk2(kbb[4], kbb[5]), pk2(kbb[6], kbb[7])};
            u32x4 va, vb;
#pragma unroll
            for (int j = 0; j < 4; ++j) { va[j] = (vraw[2 * j] & 0xffffu) | (vraw[2 * j + 1] << 16); vb[j] = (vraw[2 * j] >> 16) | (vraw[2 * j + 1] & 0xffff0000u); }
            vp[0] = va; vp[LDT * 2 / 16] = vb;
        }
        if (wid == 0) { *(LAS f32x2*)(DV + 2 * lane) = (f32x2){__builtin_amdgcn_exp2f(bta), __builtin_amdgcn_exp2f(btb)}; dsfa += bta; dsfb += btb; }
        pba += tba; pbb += tbb;
        if (ci + 1 < SEGCH) {
            const unsigned e0 = (unsigned)(((seg * SEGCH + ci + 1) * 64 + wid * 8) * D + h * 128 + 2 * lane);
#pragma unroll
            for (int i = 0; i < 8; ++i) lraw[i] = *(const unsigned*)(LFp + (e0 + (unsigned)(i * D)));
#pragma unroll
            for (int i = 0; i < 8; ++i) braw[i] = *(const unsigned*)(LBp + (e0 + (unsigned)(i * D)));
#pragma unroll
            for (int i = 0; i < 8; ++i) vraw[i] = *(const unsigned*)(Vp + (e0 + (unsigned)(i * D)));
        }
        LBAR();
        {
            const int kb = wid >> 1;
#pragma unroll
            for (int j = 0; j < 2; ++j) {
                const int vb = 2 * (wid & 1) + j;
#pragma unroll
                for (int i = 0; i < 16; ++i) Sf[j][i] *= DV[kb * 32 + rowf(i, hh)];
#pragma unroll
                for (int kk = 0; kk < 4; ++kk) {
                    const bf16x8 b = *(const LAS bf16x8*)(lds + P_VT + ((vb * 32 + r) * LDT + kk * 16 + 8 * hh) * 2);
                    const bf16x8 af = *(const LAS bf16x8*)(lds + P_KF + ((kb * 32 + r) * LDT + kk * 16 + 8 * hh) * 2);
                    const bf16x8 ab = *(const LAS bf16x8*)(lds + P_KB + ((kb * 32 + r) * LDT + kk * 16 + 8 * hh) * 2);
                    Sf[j] = MFMA32(af, b, Sf[j]); Sb[j] = MFMA32(ab, b, Sb[j]);
                }
            }
        }
        LBAR();
    }
    {
        const int r = lane & 31, hh = lane >> 5, kb = wid >> 1;
        float* spf = SEG + (size_t)((h * 2 + 0) * NSEG + seg) * 16384; float* spb = SEG + (size_t)((h * 2 + 1) * NSEG + seg) * 16384;
#pragma unroll
        for (int j = 0; j < 2; ++j) { const int vc = (2 * (wid & 1) + j) * 32 + r;
#pragma unroll
            for (int i = 0; i < 16; ++i) { spf[(kb * 32 + rowf(i, hh)) * 128 + vc] = Sf[j][i]; spb[(kb * 32 + rowf(i, hh)) * 128 + vc] = Sb[j][i]; } }
        if (wid == 0) {
            *(f32x2*)(DSEG + ((h * 2 + 0) * NSEG + seg) * 128 + 2 * lane) = (f32x2){__builtin_amdgcn_exp2f(dsfa), __builtin_amdgcn_exp2f(dsfb)};
            *(f32x2*)(DSEG + ((h * 2 + 1) * NSEG + seg) * 128 + 2 * lane) = (f32x2){__builtin_amdgcn_exp2f(pba), __builtin_amdgcn_exp2f(pbb)};
        }
    }
}

__device__ __forceinline__ void scan_combine(unsigned char* ws, int tid) {
    float* SEG = (float*)(ws + WS_SEG); const float* DSEG = (const float*)(ws + WS_DSEG);
    const int gt = blockIdx.x * 512 + tid, NGT = gridDim.x * 512;
    for (int e = gt; e < 16 * 16384; e += NGT) {
        const int hd = e >> 14, kv = e & 16383, k = kv >> 7, dir = hd & 1;
        float* base = SEG + (size_t)hd * NSEG * 16384 + kv; const float* db = DSEG + hd * NSEG * 128 + k;
        float tv[NSEG], dv[NSEG];
#pragma unroll
        for (int st = 0; st < NSEG; ++st) { tv[st] = base[(size_t)st * 16384]; dv[st] = db[st * 128]; }
        float s = 0.f;
        if (dir == 0) {
#pragma unroll
            for (int st = 0; st < NSEG; ++st) { base[(size_t)st * 16384] = s; s = dv[st] * s + tv[st]; }
        } else {
#pragma unroll
            for (int st = NSEG - 1; st >= 0; --st) { base[(size_t)st * 16384] = s; s = dv[st] * s + tv[st]; }
        }
    }
}

__device__ __forceinline__ void sgu_item(LAS unsigned char* lds, unsigned char* ws, const float* lng, const float* lnb, const float* sgb, int item, int tid, int wid, int lane) {
    const int cidx = item >> 1, half = item & 1, tok0 = cidx * 128;
    const int r = lane & 31, hh = lane >> 5;
    const bf16* GV = (const bf16*)(ws + WS_GV); const bf16* U = (const bf16*)(ws + WS_U); bf16* BO = (bf16*)(ws + WS_BO); const bf16* SGW = (const bf16*)(ws + WS_SGW);
    constexpr int L_WS = 0, L_VN = 34816, L_MU = 52224, L_RSD = 52736, L_SG = 53248, LDSG = 68;
    LAS float* MU = (LAS float*)(lds + L_MU); LAS float* RSD = (LAS float*)(lds + L_RSD); LAS float* STG = (LAS float*)(lds + L_SG);
    const int e = tid & 63, sp = tid >> 6;
    u32x4 wsreg[4]; unsigned short gvs[16];
    {
        const int g = half * 4;
#pragma unroll
        for (int i = 0; i < 4; ++i) { const int idx = tid + 512 * i; wsreg[i] = *(const u32x4*)(SGW + (size_t)g * 16384 + (idx >> 4) * 128 + (idx & 15) * 8); }
#pragma unroll
        for (int i = 0; i < 16; ++i) gvs[i] = GV[(size_t)(tok0 + sp * 16 + i) * SGWD + g * 64 + e];
    }
    {
        u32x4 graw[16];
#pragma unroll
        for (int i = 0; i < 16; ++i) graw[i] = *(const u32x4*)(GV + (size_t)(tok0 + wid * 16 + i) * SGWD + lane * 8);
#pragma unroll
        for (int i = 0; i < 16; ++i) {
            const int s = wid * 16 + i; f32x4 a, b; { const u32x4 w = graw[i];
                a[0] = __uint_as_float(w.x << 16); a[1] = __uint_as_float(w.x & 0xffff0000u); a[2] = __uint_as_float(w.y << 16); a[3] = __uint_as_float(w.y & 0xffff0000u);
                b[0] = __uint_as_float(w.z << 16); b[1] = __uint_as_float(w.z & 0xffff0000u); b[2] = __uint_as_float(w.w << 16); b[3] = __uint_as_float(w.w & 0xffff0000u); }
            const float mean = wave_sum((a[0] + a[1]) + (a[2] + a[3]) + (b[0] + b[1]) + (b[2] + b[3])) * (1.f / SGWD);
            a = a - mean; b = b - mean;
            const float var = wave_sum((a[0] * a[0] + a[1] * a[1]) + (a[2] * a[2] + a[3] * a[3]) + (b[0] * b[0] + b[1] * b[1]) + (b[2] * b[2] + b[3] * b[3])) * (1.f / SGWD);
            if (lane == 0) { MU[s] = mean; RSD[s] = rsqrtf(var + EPS); }
        }
    }
    LBAR();
    for (int gi = 0; gi < 4; ++gi) {
        const int g = half * 4 + gi;
#pragma unroll
        for (int i = 0; i < 4; ++i) { const int idx = tid + 512 * i; *(LAS u32x4*)(lds + L_WS + ((idx >> 4) * LDQ + (idx & 15) * 8) * 2) = wsreg[i]; }
        {
            const float gg = lng[g * 64 + e], bb = lnb[g * 64 + e];
            unsigned pkd[8];
#pragma unroll
            for (int i = 0; i < 8; ++i) { const int s = sp * 16 + 2 * i;
                pkd[i] = pk2((bf2f(gvs[2 * i]) - MU[s]) * RSD[s] * gg + bb, (bf2f(gvs[2 * i + 1]) - MU[s + 1]) * RSD[s + 1] * gg + bb); }
            LAS u32x4* vp = (LAS u32x4*)(lds + L_VN + (e * LDQ + sp * 16) * 2);
            vp[0] = (u32x4){pkd[0], pkd[1], pkd[2], pkd[3]}; vp[1] = (u32x4){pkd[4], pkd[5], pkd[6], pkd[7]};
        }
        const int et = tid >> 3, eg8 = 8 * (tid & 7);
        u32x4 ureg[2];
#pragma unroll
        for (int j = 0; j < 2; ++j) ureg[j] = *(const u32x4*)(U + (size_t)(tok0 + et + 64 * j) * SGWD + g * 64 + eg8);
        if (gi + 1 < 4) {
#pragma unroll
            for (int i = 0; i < 4; ++i) { const int idx = tid + 512 * i; wsreg[i] = *(const u32x4*)(SGW + (size_t)(g + 1) * 16384 + (idx >> 4) * 128 + (idx & 15) * 8); }
#pragma unroll
            for (int i = 0; i < 16; ++i) gvs[i] = GV[(size_t)(tok0 + sp * 16 + i) * SGWD + (g + 1) * 64 + e];
        }
        LBAR();
        const int tb = wid >> 1, eb = wid & 1;
        f32x16 acc;
#pragma unroll
        for (int i = 0; i < 16; ++i) acc[i] = 0.f;
#pragma unroll
        for (int kk = 0; kk < 8; ++kk) {
            const bf16x8 a = *(const LAS bf16x8*)(lds + L_WS + ((tb * 32 + r) * LDQ + kk * 16 + 8 * hh) * 2);
            const bf16x8 b = *(const LAS bf16x8*)(lds + L_VN + ((eb * 32 + r) * LDQ + kk * 16 + 8 * hh) * 2);
            acc = MFMA32(a, b, acc);
        }
#pragma unroll
        for (int i = 0; i < 16; ++i) STG[(tb * 32 + rowf(i, hh)) * LDSG + eb * 32 + r] = acc[i];
        LBAR();
#pragma unroll
        for (int j = 0; j < 2; ++j) {
            const int t = et + 64 * j; const float bs = sgb[g * 128 + t];
            f32x4 a = *(const LAS f32x4*)(STG + t * LDSG + eg8), b = *(const LAS f32x4*)(STG + t * LDSG + eg8 + 4);
            f32x4 ua, ub; { const u32x4 w = ureg[j];
                ua[0] = __uint_as_float(w.x << 16); ua[1] = __uint_as_float(w.x & 0xffff0000u); ua[2] = __uint_as_float(w.y << 16); ua[3] = __uint_as_float(w.y & 0xffff0000u);
                ub[0] = __uint_as_float(w.z << 16); ub[1] = __uint_as_float(w.z & 0xffff0000u); ub[2] = __uint_as_float(w.w << 16); ub[3] = __uint_as_float(w.w & 0xffff0000u); }
            st8bf(BO + (size_t)(tok0 + t) * SGWD + g * 64 + eg8, (a + bs) * ua, (b + bs) * ub);
        }
        LBAR();
    }
}

#define RLX_AGENT __ATOMIC_RELAXED, __HIP_MEMORY_SCOPE_AGENT
#define XB_TMO      128
#define XB_XCNT(j)  (256  + 64 * (j))
#define XB_XSUB(j)  (1280 + 64 * (j))
#define XB_XGEN(j)  (2304 + 64 * (j))
#define XB_TOP      3328
#define XB_TOPGEN   3392
#define XCD_BAR_WORDS 3456
#define XB_SPIN_CAP (1u << 18)

__device__ __forceinline__ unsigned xb_ld(unsigned* p)              { return __hip_atomic_load(p, __ATOMIC_RELAXED, __HIP_MEMORY_SCOPE_AGENT); }
__device__ __forceinline__ unsigned xb_add(unsigned* p, unsigned v) { return __hip_atomic_fetch_add(p, v, __ATOMIC_RELAXED, __HIP_MEMORY_SCOPE_AGENT); }
__device__ __forceinline__ unsigned xb_xcc_id() { return (unsigned)__builtin_amdgcn_s_getreg((3 << 11) | 20) & 0xFu; }
#define XB_SPIN(cond, bar) do { unsigned _sp = 0; while (cond) { __builtin_amdgcn_s_sleep(1); \
    if ((++_sp & 255u) == 0u) { if (xb_ld(&(bar)[XB_TMO])) break; if (_sp > XB_SPIN_CAP) { atomicAdd(&(bar)[XB_TMO], 1u); break; } } } } while (0)

struct XcdBarrier {
    unsigned* bar; unsigned x;
    volatile LAS unsigned* st;
};

__device__ __forceinline__ XcdBarrier xcd_barrier_post(unsigned* bar, volatile LAS unsigned* st) {
    XcdBarrier b; b.bar = bar; b.x = xb_xcc_id(); b.st = st;
    if (threadIdx.x == 0) (void)xb_add(&bar[XB_XCNT(b.x)], 1u);
    return b;
}
__device__ __forceinline__ void xcd_barrier_complete(unsigned* bar, unsigned x, unsigned& nloc, unsigned& nx) {
    const unsigned G = gridDim.x * gridDim.y * gridDim.z;
    unsigned sum, cnt, mine, sp = 0u;
    for (;;) {
        sum = 0u; cnt = 0u; mine = 0u;
#pragma unroll
        for (unsigned j = 0; j < 16; ++j) { const unsigned c = xb_ld(&bar[XB_XCNT(j)]); sum += c; cnt += (c > 0u) ? 1u : 0u; mine = (j == x) ? c : mine; }
        if (sum == G) break;
        __builtin_amdgcn_s_sleep(1);
        if ((++sp & 255u) == 0u) { if (xb_ld(&bar[XB_TMO])) break; if (sp > XB_SPIN_CAP) { atomicAdd(&bar[XB_TMO], 1u); break; } }
    }
    nloc = mine > 0u ? mine : 1u; nx = cnt > 0u ? cnt : 1u;
}

__device__ __forceinline__ void xcd_barrier(const XcdBarrier& b) {
    asm volatile("s_waitcnt vmcnt(0)" ::: "memory");
    __syncthreads();
    if (threadIdx.x == 0) {
        unsigned* bar = b.bar;
        __builtin_amdgcn_s_waitcnt(0);
        unsigned nloc = b.st[0], nx = b.st[1];
        if (nloc == 0u) { xcd_barrier_complete(bar, b.x, nloc, nx); b.st[0] = nloc; b.st[1] = nx; }
        const unsigned old = xb_add(&bar[XB_XSUB(b.x)], 1u);
        const unsigned gen = old / nloc;
        if (old + 1u == (gen + 1u) * nloc) {
            __builtin_amdgcn_fence(__ATOMIC_RELEASE, "agent");
            asm volatile("s_waitcnt vmcnt(0)" ::: "memory");
            const unsigned og = xb_add(&bar[XB_TOP], 1u);
            const unsigned tg = og / nx;
            if (og + 1u == (tg + 1u) * nx) xb_add(&bar[XB_TOPGEN], 1u);
            else XB_SPIN(xb_ld(&bar[XB_TOPGEN]) == tg, bar);
            __builtin_amdgcn_fence(__ATOMIC_ACQUIRE, "agent");
            xb_add(&bar[XB_XGEN(b.x)], 1u);
            asm volatile("s_waitcnt vmcnt(0)" ::: "memory");
        } else {
            XB_SPIN(xb_ld(&bar[XB_XGEN(b.x)]) == gen, bar);
            __builtin_amdgcn_fence(__ATOMIC_ACQUIRE, "agent");
            asm volatile("s_waitcnt vmcnt(0)" ::: "memory");
        }
    }
    __syncthreads();
}

constexpr size_t WS_BAR = 512 * 1024;
constexpr size_t WS_CNT = 528 * 1024;
constexpr size_t WS_XB = 1280 * 1024;
constexpr size_t CTL_ZERO_BYTES = (528 + 192 - 512) * 1024;
constexpr int LDS_ST = LDS_BYTES - 16;
typedef const __attribute__((address_space(4))) Args* KArgs;
struct RowStat {
    float* xbuf; unsigned* cnt;
    __device__ __forceinline__ void run(const pg8::f32x4 (&v)[2][2][4][2], const pg8::Unit& u, int wr, int wc, int fr, int fq, LAS unsigned char* lds, int wid, int lane) const {
        LAS float* P = (LAS float*)lds;
        LAS float* S = (LAS float*)(lds + 8192);
#pragma unroll
        for (int ai = 0; ai < 2; ++ai)
#pragma unroll
            for (int m = 0; m < 4; ++m) {
                float q = 0.f;
#pragma unroll
                for (int bj = 0; bj < 2; ++bj)
#pragma unroll
                    for (int n = 0; n < 2; ++n) { const pg8::f32x4 x = v[ai][bj][m][n]; q += (x[0] * x[0] + x[1] * x[1]) + (x[2] * x[2] + x[3] * x[3]); }
                q += __shfl_xor(q, 16); q += __shfl_xor(q, 32);
                if (fq == 0) P[(ai * 128 + wr * 64 + m * 16 + fr) * 4 + wc] = q;
            }
        asm volatile("s_waitcnt lgkmcnt(0)" ::: "memory"); __builtin_amdgcn_s_barrier(); asm volatile("" ::: "memory");
        const int row = wid * 32 + (lane & 31);
        if (lane < 32) {
            const float t = (P[row * 4 + 0] + P[row * 4 + 1]) + (P[row * 4 + 2] + P[row * 4 + 3]);
            __hip_atomic_store(xbuf + ((size_t)(u.pm * 256 + row) * 4 + u.pn), t, __ATOMIC_RELAXED, __HIP_MEMORY_SCOPE_AGENT);
        }
        asm volatile("s_waitcnt vmcnt(0)" ::: "memory");
        if (lane == 0) __hip_atomic_fetch_add(cnt + 64 * u.pm, 1u, __ATOMIC_RELAXED, __HIP_MEMORY_SCOPE_AGENT);
        if (wid == 0) {
            unsigned sp = 0;
            while ((unsigned)__builtin_amdgcn_readfirstlane(__hip_atomic_load(cnt + 64 * u.pm, __ATOMIC_RELAXED, __HIP_MEMORY_SCOPE_AGENT)) < 32u) { if (++sp > (1u << 20)) break; __builtin_amdgcn_s_sleep(2); }
            __builtin_amdgcn_fence(__ATOMIC_ACQUIRE, "agent");
        }
        asm volatile("s_waitcnt vmcnt(0) lgkmcnt(0)" ::: "memory"); __builtin_amdgcn_s_barrier(); asm volatile("" ::: "memory");
        if (lane < 32) {
            const float* slot = xbuf + (size_t)(u.pm * 256 + row) * 4; float tot = 0.f;
#pragma unroll
            for (int t = 0; t < 4; ++t) tot += __hip_atomic_load(slot + t, __ATOMIC_RELAXED, __HIP_MEMORY_SCOPE_AGENT);
            S[row] = rsqrtf(tot * (1.f / D) + EPS);
        }
        asm volatile("s_waitcnt lgkmcnt(0)" ::: "memory"); __builtin_amdgcn_s_barrier(); asm volatile("" ::: "memory");
    }
};
struct EpiG4Fused {
    static constexpr bool PERM = true, AFTER_DRAIN = true; static constexpr int MID = 0;
    int l, b;
    __device__ __forceinline__ void fused(pg8::f32x4 (&acc)[2][2][4][2], const pg8::Unit& u, int wr, int wc, int fr, int fq, LAS unsigned char* lds, int wid, int lane) const {
        KArgs ka = (KArgs)__builtin_amdgcn_kernarg_segment_ptr(); asm volatile("" : "+s"(ka));
        unsigned char* ws = ka->ws;
        const float* xin = l == 0 ? ka->in[0] : ka->out; float* xout = ka->out;
        const float* g1 = ka->in[14] + l * D; const float* g2 = ka->in[15] + l * D;
        bf16* H2o = (bf16*)(ws + WS_MIX);
        const int inst = (l * 2 + b) * 2;
        const RowStat st1{(float*)(ws + WS_XB), (unsigned*)(ws + WS_CNT) + (size_t)inst * 4096};
        const RowStat st2{(float*)(ws + WS_XB) + 65536, (unsigned*)(ws + WS_CNT) + (size_t)(inst + 1) * 4096};
        const LAS float* S = (const LAS float*)(lds + 8192);
        const int col0 = u.pn * 256 + wc * 32 + 8 * fq;
        f32x4 pre[4][2][2];
#pragma unroll
        for (int m = 0; m < 4; ++m) { const size_t off = (size_t)(b * TB + u.pm * 256 + wr * 64 + m * 16 + fr) * D + col0;
#pragma unroll
            for (int bj = 0; bj < 2; ++bj)
#pragma unroll
                for (int n = 0; n < 2; ++n) pre[m][bj][n] = *(const f32x4*)(xin + off + bj * 128 + n * 4); }
        st1.run(acc, u, wr, wc, fr, fq, lds, wid, lane);
#pragma unroll
        for (int ai = 0; ai < 2; ++ai)
#pragma unroll
            for (int m = 0; m < 4; ++m) { const int r = ai * 128 + wr * 64 + m * 16 + fr; const float s1 = S[r]; const size_t off = (size_t)(b * TB + u.pm * 256 + r) * D + col0;
#pragma unroll
                for (int bj = 0; bj < 2; ++bj)
#pragma unroll
                    for (int n = 0; n < 2; ++n) { const f32x4 bs = pre[m][bj][n]; const f32x4 gg = *(const f32x4*)(g1 + col0 + bj * 128 + n * 4);
                        acc[ai][bj][m][n] = bs + acc[ai][bj][m][n] * s1 * gg; }
                asm volatile("" : "+v"(acc[ai][0][m][0]), "+v"(acc[ai][0][m][1]), "+v"(acc[ai][1][m][0]), "+v"(acc[ai][1][m][1]));
                if (ai == 0 && m == 3) {
                    asm volatile("" ::: "memory");
#pragma unroll
                    for (int m2 = 0; m2 < 4; ++m2) { const size_t off2 = (size_t)(b * TB + u.pm * 256 + 128 + wr * 64 + m2 * 16 + fr) * D + col0;
#pragma unroll
                        for (int bj = 0; bj < 2; ++bj)
#pragma unroll
                            for (int n = 0; n < 2; ++n) pre[m2][bj][n] = *(const f32x4*)(xin + off2 + bj * 128 + n * 4); }
                } }
        st2.run(acc, u, wr, wc, fr, fq, lds, wid, lane);
#pragma unroll
        for (int ai = 0; ai < 2; ++ai)
#pragma unroll
            for (int m = 0; m < 4; ++m) { const int r = ai * 128 + wr * 64 + m * 16 + fr; const float s2 = S[r]; const size_t off = (size_t)(b * TB + u.pm * 256 + r) * D + col0;
#pragma unroll
                for (int bj = 0; bj < 2; ++bj) { const f32x4 x0 = acc[ai][bj][m][0], x1 = acc[ai][bj][m][1];
                    *(f32x4*)(xout + off + bj * 128) = x0; *(f32x4*)(xout + off + bj * 128 + 4) = x1;
                    const f32x4 h0 = *(const f32x4*)(g2 + col0 + bj * 128), h1 = *(const f32x4*)(g2 + col0 + bj * 128 + 4);
                    st8bf(H2o + off + bj * 128, x0 * s2 * h0, x1 * s2 * h1); }
                asm volatile("" ::: "memory"); }
    }
};
struct EpiG6Fused {
    static constexpr bool PERM = true, AFTER_DRAIN = true; static constexpr int MID = 0;
    int l, b;
    __device__ __forceinline__ void fused(pg8::f32x4 (&acc)[2][2][4][2], const pg8::Unit& u, int wr, int wc, int fr, int fq, LAS unsigned char* lds, int wid, int lane) const {
        KArgs ka = (KArgs)__builtin_amdgcn_kernarg_segment_ptr(); asm volatile("" : "+s"(ka));
        unsigned char* ws = ka->ws;
        float* X = ka->out; const float* g3 = ka->in[19] + l * D;
        bf16* H2o = (bf16*)(ws + WS_H2);
        const RowStat st{(float*)(ws + WS_XB), (unsigned*)(ws + WS_CNT) + (size_t)(8 + l * 2 + b) * 4096};
        const LAS float* S = (const LAS float*)(lds + 8192);
        const int col0 = u.pn * 256 + wc * 32 + 8 * fq;
        f32x4 pre[4][2][2];
#pragma unroll
        for (int m = 0; m < 4; ++m) { const size_t off = (size_t)(b * TB + u.pm * 256 + wr * 64 + m * 16 + fr) * D + col0;
#pragma unroll
            for (int bj = 0; bj < 2; ++bj)
#pragma unroll
                for (int n = 0; n < 2; ++n) pre[m][bj][n] = *(const f32x4*)(X + off + bj * 128 + n * 4); }
        st.run(acc, u, wr, wc, fr, fq, lds, wid, lane);
#pragma unroll
        for (int ai = 0; ai < 2; ++ai)
#pragma unroll
            for (int m = 0; m < 4; ++m) { const int r = ai * 128 + wr * 64 + m * 16 + fr; const float s3 = S[r]; const size_t off = (size_t)(b * TB + u.pm * 256 + r) * D + col0;
#pragma unroll
                for (int bj = 0; bj < 2; ++bj) {
                    const f32x4 b0 = pre[m][bj][0], b1 = pre[m][bj][1];
                    const f32x4 h0 = *(const f32x4*)(g3 + col0 + bj * 128), h1 = *(const f32x4*)(g3 + col0 + bj * 128 + 4);
                    const f32x4 x0 = b0 + acc[ai][bj][m][0] * s3 * h0, x1 = b1 + acc[ai][bj][m][1] * s3 * h1;
                    *(f32x4*)(X + off + bj * 128) = x0; *(f32x4*)(X + off + bj * 128 + 4) = x1;
                    st8bf(H2o + off + bj * 128, x0, x1); }
                if (ai == 0 && m == 3) {
                    asm volatile("" ::: "memory");
#pragma unroll
                    for (int m2 = 0; m2 < 4; ++m2) { const size_t off2 = (size_t)(b * TB + u.pm * 256 + 128 + wr * 64 + m2 * 16 + fr) * D + col0;
#pragma unroll
                        for (int bj = 0; bj < 2; ++bj)
#pragma unroll
                            for (int n = 0; n < 2; ++n) pre[m2][bj][n] = *(const f32x4*)(X + off2 + bj * 128 + n * 4); }
                } }
    }
};
constexpr int PH_PER_LAYER = 18, N_PHASES = 2 * PH_PER_LAYER;
#ifndef PROBE_MASK
#define PROBE_MASK 0
#endif
__global__ void __launch_bounds__(512, 2) mega(Args a) {
    extern __shared__ __attribute__((aligned(16))) unsigned char lds_raw[];
    LAS unsigned char* lds = (LAS unsigned char*)lds_raw;
    if (threadIdx.x < 4) ((LAS unsigned*)(lds + LDS_ST))[threadIdx.x] = 0u;
    __syncthreads();
    (void)xcd_barrier_post((unsigned*)(a.ws + WS_BAR), (volatile LAS unsigned*)(lds + LDS_ST));
    int rep = 0;
    for (int st = a.ph_lo; ; ) {
        int tid = threadIdx.x; asm volatile("" : "+v"(tid));
        KArgs ka = (KArgs)__builtin_amdgcn_kernarg_segment_ptr(); asm volatile("" : "+s"(ka));
        unsigned char* ws = ka->ws; float* X = ka->out;
        int bid = blockIdx.x; asm volatile("" : "+s"(bid));
        const int lane = tid & 63, wave = __builtin_amdgcn_readfirstlane(tid >> 6);
        const int l = st / PH_PER_LAYER, idx = st % PH_PER_LAYER;
        const float* xin = l == 0 ? ka->in[0] : X;
        const bool fusedR1 = (gridDim.x == 256);
        if (fusedR1 && idx == 13) { ++st; continue; }
        const int kind = idx == 0 ? 0 : (idx <= 12 ? 1 + (idx - 1) % 6 : idx - 6);
        if (idx == 0) {
            prologue(ka, ws, l, lds, tid, wave, lane);
            rows_r0(xin, ka->in[2] + l * D, (bf16*)(ws + WS_H), 0, TB, wave, lane);
            if (fusedR1) {
                const float* pr = ka->in[1] + (size_t)l * T * PLE; bf16* pb = (bf16*)(ws + WS_PB2);
                for (size_t i = (size_t)bid * 512 + tid; i < (size_t)T * PLE / 8; i += (size_t)gridDim.x * 512) { f32x4 a, b; ldrow8(pr + 8 * i, a, b); st8bf(pb + 8 * i, a, b); }
            }
        } else if (idx <= 12) {
            const int b = (idx - 1) / 6, sub = (idx - 1) % 6;
            if (sub == 0) {
                EpiG1 E{ws, l == 0 ? 1 : 0};
                run_gemm(lds, (const bf16*)(ws + WS_H), (const bf16*)(ws + W_IN), TB, NIN, D, E, tid, bid);
            } else if (sub == 1) {
                for (int it = bid; it < 8 * NSEG; it += gridDim.x) scan_p1_item(lds, ws, it, tid, wave, lane);
                for (int it = bid; it < 128 * 2; it += gridDim.x) sgu_item(lds, ws, ka->in[9] + l * SGWD, ka->in[10] + l * SGWD, ka->in[8] + l * 1024, it, tid, wave, lane);
                if (b == 0) rows_r0(xin, ka->in[2] + l * D, (bf16*)(ws + WS_H), TB, TB, wave, lane);
            } else if (sub == 2) {
                scan_combine(ws, tid);
            } else if (sub == 3) {
                for (int it = bid; it < 8 * NSEG; it += gridDim.x) scan_item<true>(lds, ws, ka->in[6] + l * D, it, tid, wave, lane);
            } else if (sub == 4) {
                { EpiRow8<FG2> E{FG2{ws}};
                  run_gemm(lds, (const bf16*)(ws + WS_AO), (const bf16*)(ws + W_A), TB, D, D, E, tid, bid); }
                { int tid2 = threadIdx.x; asm volatile("" : "+v"(tid2)); KArgs ka2 = (KArgs)__builtin_amdgcn_kernarg_segment_ptr(); asm volatile("" : "+s"(ka2)); unsigned char* ws2 = ka2->ws; int bid2 = blockIdx.x; asm volatile("" : "+s"(bid2));
                  EpiRow8<FG3> E{FG3{ws2}};
                  run_gemm(lds, (const bf16*)(ws2 + WS_BO), (const bf16*)(ws2 + W_B), TB, D, SGWD, E, tid2, bid2); }
            } else if (fusedR1) {
                EpiG4Fused E{l, b};
                run_gemm<EpiG4Fused, false>(lds, (const bf16*)(ws + WS_Q), (const bf16*)(ws + W_O), TB, D, D, E, tid, bid);
            } else {
                EpiRow8<FStore> E{FStore{ws, WS_MIX + (size_t)b * TB * D * 2}};
                run_gemm(lds, (const bf16*)(ws + WS_Q), (const bf16*)(ws + W_O), TB, D, D, E, tid, bid);
            }
        } else if (idx == 13) {
            rows_r12(xin, X, (const bf16*)(ws + WS_MIX), ka->in[14] + l * D, ka->in[15] + l * D, (bf16*)(ws + WS_H2), nullptr, nullptr, wave, lane);
        } else if (idx == 14) {
            EpiSwiglu E{ws};
            run_gemm(lds, (const bf16*)(ws + (fusedR1 ? WS_MIX : WS_H2)), (const bf16*)(ws + W_GU), T, 2 * FF, D, E, tid, bid);
        } else if (fusedR1 && (idx == 15 || idx == 16)) {
            const int b = idx - 15;
            EpiG6Fused E{l, b};
            run_gemm<EpiG6Fused, false>(lds, (const bf16*)(ws + WS_HID) + (size_t)b * TB * FF, (const bf16*)(ws + W_DN), TB, D, FF, E, tid, bid);
        } else if (idx == 15) {
            EpiRow8<FStore> E{FStore{ws, WS_MIX}};
            run_gemm(lds, (const bf16*)(ws + WS_HID), (const bf16*)(ws + W_DN), T, D, FF, E, tid, bid);
        } else if (idx == 16) {
            rows_r12(X, X, (const bf16*)(ws + WS_MIX), ka->in[19] + l * D, nullptr, (bf16*)(ws + WS_H2), ka->in[1] + (size_t)l * T * PLE, (bf16*)(ws + WS_PB), wave, lane);
        } else {
            { EpiRow8<FSig> E{FSig{ws}};
              run_gemm(lds, (const bf16*)(ws + WS_H2), (const bf16*)(ws + W_PG), T, D, D, E, tid, bid); }
            { int tid2 = threadIdx.x; asm volatile("" : "+v"(tid2)); KArgs ka2 = (KArgs)__builtin_amdgcn_kernarg_segment_ptr(); asm volatile("" : "+s"(ka2)); unsigned char* ws2 = ka2->ws; int bid2 = blockIdx.x; asm volatile("" : "+s"(bid2));
              EpiRow8<FG8> E{FG8{ws2, ka2->out}};
              run_gemm(lds, (const bf16*)(ws2 + (gridDim.x == 256 ? WS_PB2 : WS_PB)), (const bf16*)(ws2 + W_PL), T, D, PLE, E, tid2, bid2); }
        }
        if (PROBE_MASK != 0 && rep == 0 && ((PROBE_MASK >> kind) & 1)) { rep = 1; __syncthreads(); continue; }
        rep = 0;
        if (st + 1 >= ka->ph_hi) break;
        if (ka->ph_lo < 0) cg::this_grid().sync();
        else { XcdBarrier xb; xb.bar = (unsigned*)(ka->ws + WS_BAR); xb.x = xb_xcc_id(); xb.st = (volatile LAS unsigned*)(lds + LDS_ST); xcd_barrier(xb); }
        ++st;
    }
}

extern "C" void kernel_launch(void* const* d_in, const int* in_sizes, int n_in, void* d_out, int out_size, void* d_ws, size_t ws_size, hipStream_t stream) {
    static int grid = 0;
    if (grid == 0) {
        if (n_in != 22 || ws_size < WS_END) { fprintf(stderr, "kernel_launch: unexpected n_in %d / ws_size %zu (need %zu)\n", n_in, ws_size, (size_t)WS_END); grid = -1; return; }
        int dev = 0, cus = 0, per_cu = 0;
        hipGetDevice(&dev); hipDeviceGetAttribute(&cus, hipDeviceAttributeMultiprocessorCount, dev);
        hipFuncSetAttribute((const void*)mega, hipFuncAttributeMaxDynamicSharedMemorySize, LDS_BYTES);
        hipOccupancyMaxActiveBlocksPerMultiprocessor(&per_cu, (const void*)mega, 512, LDS_BYTES);
        if (per_cu < 1) per_cu = 1;
        (void)hipGetLastError();
        grid = cus * per_cu;
    }
    if (grid < 0) return;
    if (hipMemsetAsync((char*)d_ws + WS_BAR, 0, CTL_ZERO_BYTES, stream) != hipSuccess) { fprintf(stderr, "memset failed\n"); return; }
    Args a{};
    for (int i = 0; i < 22; ++i) a.in[i] = (const float*)d_in[i];
    a.out = (float*)d_out; a.ws = (unsigned char*)d_ws; a.ph_lo = 0; a.ph_hi = N_PHASES;
    void* args[] = {&a};
    hipError_t e = hipLaunchCooperativeKernel((const void*)mega, dim3(grid), dim3(512), args, LDS_BYTES, stream);
    if (e != hipSuccess) fprintf(stderr, "cooperative launch failed: %s (grid %d)\n", hipGetErrorString(e), grid);
}
```

```cpp
#include <hip/hip_runtime.h>
#include <cstdio>
#include <cstdint>
namespace pg8 {
#define PG8_LAS __attribute__((address_space(3)))
typedef unsigned short bf16_t;
typedef short bf16x8 __attribute__((ext_vector_type(8)));
typedef float f32x4 __attribute__((ext_vector_type(4)));
typedef unsigned u32x4 __attribute__((ext_vector_type(4)));
constexpr int BM = 256, BK = 64, HALF = 128, HTB = HALF * BK * 2  , STAGE_BYTES = 8 * HTB, NXCD = 8, WGM = 4;

__host__ __device__ __forceinline__ int lds_byte(int r, int c) { const int st = (r >> 4) * 2 + (c >> 5), rr = r & 15, cc = c & 31, ob = rr * 64 + cc * 2; return st * 1024 + (ob ^ (((ob >> 9) & 1) << 5)); }
__host__ __device__ __forceinline__ void stage_rc(int b, int& R, int& C) { const int st = b / 1024, sb = b % 1024, swz = sb ^ (((sb >> 9) & 1) << 5); R = (st >> 1) * 16 + swz / 64; C = (st & 1) * 32 + (swz % 64) / 2; }
__host__ __device__ __forceinline__ int perm32(int rho) { const int n = rho >> 4, i = rho & 15; return 8 * (i >> 2) + 4 * n + (i & 3); }

struct Unit { int pm, pn; };
struct Gemm { const bf16_t* A; const bf16_t* Bt; int M, N, K; };

struct StaticOrder {
    int nM, nN, nwg, G, c;
    __host__ __device__ void init(int M, int N, int G_, int c_) { nM = M / BM; nN = N / BM; nwg = nM * nN; G = G_; c = c_; }
    __host__ __device__ bool next(int i, Unit& u) const {
        const long L = (long)i * G + c; if (L >= nwg) return false;
        int wgid = (int)L; { const int q = nwg / NXCD, r = nwg % NXCD, xcd = wgid % NXCD, off = wgid / NXCD; wgid = (xcd < r ? xcd * (q + 1) : r * (q + 1) + (xcd - r) * q) + off; }
        const int nig = WGM * nN, gid = wgid / nig, fm = gid * WGM, gsz = (nM - fm) < WGM ? (nM - fm) : WGM;
        u.pm = fm + ((wgid % nig) % gsz); u.pn = (wgid % nig) / gsz; return true;
    }
    __device__ __forceinline__ void a_ready(const Unit&) const {}
    __device__ __forceinline__ void done(const Unit&) const {}
};

__device__ __forceinline__ unsigned cvt_pk_bf16(float lo, float hi) { unsigned r; asm volatile("v_cvt_pk_bf16_f32 %0, %1, %2" : "=v"(r) : "v"(lo), "v"(hi)); return r; }
template <class Epi, class Sched, bool ALIGN_EPI = false, bool SP2 = false>
__device__ __forceinline__ void gemm_phase(PG8_LAS unsigned char* lds, const Gemm g, const Sched& S, const Epi& E, const int tid) {
    const int wid = __builtin_amdgcn_readfirstlane(tid >> 6), lane = tid & 63, wr = wid >> 2, wc = wid & 3, fr = lane & 15, fq = lane >> 4;
    const int K = g.K, nt = K / BK;
    unsigned voffA[2], voffB[2];
#pragma unroll
    for (int i = 0; i < 2; ++i) { int R, C; stage_rc(tid * 16 + i * 8192, R, C); const int Rb = Epi::PERM ? ((R & ~31) + perm32(R & 31)) : R;
        voffA[i] = (unsigned)(R * K + C) * 2u; voffB[i] = (unsigned)(Rb * K + C) * 2u; }
    const size_t kstep = (size_t)(BK * 2);
    const size_t hstep = (size_t)HALF * K * 2;
    const size_t tstep = 2 * hstep;
    const unsigned ldsw = (unsigned)wid * 1024u;
    const int aoff = lds_byte(wr * 64 + fr, fq * 8), boff = lds_byte(wc * 32 + fr, fq * 8);
#define PG8_SA(b, h) (((b) * 2 + (h)) * HTB)
#define PG8_SB(b, h) ((4 + (b) * 2 + (h)) * HTB)
#define PG8_STAGE(bufoff, gbase, voff) do { _Pragma("unroll") for (int _i = 0; _i < 2; ++_i) \
        __builtin_amdgcn_global_load_lds((const unsigned*)((const char*)(gbase) + (voff)[_i]), (PG8_LAS unsigned*)(lds + (bufoff) + ldsw + _i * 8192), 16, 0, 0); } while (0)
#define PG8_LDA(dst, b, h) do { _Pragma("unroll") for (int m = 0; m < 4; ++m) _Pragma("unroll") for (int k = 0; k < 2; ++k) dst[m][k] = *(const PG8_LAS bf16x8*)(lds + PG8_SA(b, h) + aoff + m * 2048 + k * 1024); } while (0)
#define PG8_LDB(dst, b, h) do { _Pragma("unroll") for (int n = 0; n < 2; ++n) _Pragma("unroll") for (int k = 0; k < 2; ++k) dst[n][k] = *(const PG8_LAS bf16x8*)(lds + PG8_SB(b, h) + boff + n * 2048 + k * 1024); } while (0)
#define PG8_MMA(ai, bj, At, Bt) do { __builtin_amdgcn_s_setprio(1); _Pragma("unroll") for (int m = 0; m < 4; ++m) _Pragma("unroll") for (int n = 0; n < 2; ++n) _Pragma("unroll") for (int k = 0; k < 2; ++k) \
        acc[ai][bj][m][n] = __builtin_amdgcn_mfma_f32_16x16x32_bf16(Bt[n][k], At[m][k], acc[ai][bj][m][n], 0, 0, 0); __builtin_amdgcn_s_setprio(0); } while (0)
#define PG8_WAIT_V(n) asm volatile("s_waitcnt vmcnt(" #n ")" ::: "memory")
#define PG8_WAIT_L(n) asm volatile("s_waitcnt lgkmcnt(" #n ")" ::: "memory")
#define PG8_BAR __builtin_amdgcn_s_barrier()
#define PG8_SCHED __builtin_amdgcn_sched_barrier(0)
    Unit cur, nxt; int ui = 0;
    if (!S.next(0, cur)) return;
    f32x4 acc[2][2][4][2];
#pragma unroll
    for (int a = 0; a < 2; ++a)
#pragma unroll
        for (int b = 0; b < 2; ++b)
#pragma unroll
            for (int m = 0; m < 4; ++m)
#pragma unroll
                for (int n = 0; n < 2; ++n) acc[a][b][m][n] = (f32x4){0.f, 0.f, 0.f, 0.f};
    bf16x8 At[4][2], B0[2][2], B1[2][2];
    const char* cA = (const char*)g.A + (size_t)cur.pm * tstep; const char* cB = (const char*)g.Bt + (size_t)cur.pn * tstep;
    S.a_ready(cur);
    if constexpr (SP2) {
        PG8_STAGE(PG8_SB(0, 0), cB, voffB); PG8_STAGE(PG8_SB(0, 1), cB + hstep, voffB); PG8_STAGE(PG8_SA(0, 0), cA, voffA); PG8_STAGE(PG8_SA(0, 1), cA + hstep, voffA);
        if (wr == 1) PG8_BAR;
        PG8_WAIT_V(2); PG8_BAR;
        PG8_STAGE(PG8_SB(1, 0), cB + kstep, voffB); PG8_STAGE(PG8_SA(1, 0), cA + kstep, voffA); PG8_STAGE(PG8_SB(1, 1), cB + hstep + kstep, voffB);
        PG8_WAIT_V(6); PG8_BAR;
    } else {
        PG8_STAGE(PG8_SB(0, 0), cB, voffB); PG8_STAGE(PG8_SA(0, 0), cA, voffA); PG8_STAGE(PG8_SB(0, 1), cB + hstep, voffB); PG8_STAGE(PG8_SA(0, 1), cA + hstep, voffA);
        if (wr == 1) PG8_BAR;
        PG8_WAIT_V(4); PG8_BAR;
        PG8_STAGE(PG8_SB(1, 0), cB + kstep, voffB); PG8_STAGE(PG8_SA(1, 0), cA + kstep, voffA); PG8_STAGE(PG8_SB(1, 1), cB + hstep + kstep, voffB);
        PG8_WAIT_V(6); PG8_BAR;
    }
    for (;;) {
        const bool has_next = S.next(ui + 1, nxt);
        const char* nA = has_next ? (const char*)g.A + (size_t)nxt.pm * tstep : cA; const char* nB = has_next ? (const char*)g.Bt + (size_t)nxt.pn * tstep : cB;
        for (int t = 0; t < nt; t += 2) {
            const bool last = (t == nt - 2);
            const char* a1 = cA + (size_t)(t + 1) * kstep;
            const char* a2 = last ? nA : cA + (size_t)(t + 2) * kstep; const char* b2 = last ? nB : cB + (size_t)(t + 2) * kstep;
            const char* a3 = a2 + kstep; const char* b3 = b2 + kstep;
            if (last && has_next) S.a_ready(nxt);
            if constexpr (SP2) {
            PG8_LDB(B0, 0, 0); PG8_LDB(B1, 0, 1); PG8_SCHED; PG8_LDA(At, 0, 0); PG8_STAGE(PG8_SA(1, 1), a1 + hstep, voffA);
            PG8_WAIT_V(8); PG8_WAIT_L(0); PG8_BAR; PG8_MMA(0, 0, At, B0); PG8_MMA(0, 1, At, B1); PG8_BAR; PG8_SCHED;
            PG8_LDA(At, 0, 1); PG8_STAGE(PG8_SB(0, 0), b2, voffB); PG8_STAGE(PG8_SB(0, 1), b2 + hstep, voffB); PG8_STAGE(PG8_SA(0, 0), a2, voffA);
            PG8_WAIT_V(8); PG8_WAIT_L(0); PG8_BAR; PG8_MMA(1, 0, At, B0); PG8_MMA(1, 1, At, B1); PG8_BAR; PG8_SCHED;
            PG8_LDB(B0, 1, 0); PG8_LDB(B1, 1, 1); PG8_SCHED; PG8_LDA(At, 1, 0); PG8_STAGE(PG8_SA(0, 1), a2 + hstep, voffA);
            PG8_WAIT_V(8); PG8_WAIT_L(0); PG8_BAR; PG8_MMA(0, 0, At, B0); PG8_MMA(0, 1, At, B1); PG8_BAR; PG8_SCHED;
            PG8_LDA(At, 1, 1); PG8_STAGE(PG8_SB(1, 0), b3, voffB); PG8_STAGE(PG8_SB(1, 1), b3 + hstep, voffB); PG8_STAGE(PG8_SA(1, 0), a3, voffA);
            PG8_WAIT_V(8); PG8_WAIT_L(0); PG8_BAR; PG8_MMA(1, 0, At, B0); PG8_MMA(1, 1, At, B1); PG8_BAR; PG8_SCHED;
            } else {
            PG8_LDB(B0, 0, 0); PG8_SCHED; PG8_LDA(At, 0, 0); PG8_STAGE(PG8_SA(1, 1), a1 + hstep, voffA);
            PG8_WAIT_L(8); PG8_BAR; PG8_WAIT_L(0); PG8_MMA(0, 0, At, B0); PG8_BAR; PG8_SCHED;
            PG8_LDB(B1, 0, 1); PG8_STAGE(PG8_SB(0, 0), b2, voffB);
            PG8_BAR; PG8_WAIT_L(0); PG8_MMA(0, 1, At, B1); PG8_BAR;
            PG8_LDA(At, 0, 1); PG8_STAGE(PG8_SA(0, 0), a2, voffA);
            PG8_BAR; PG8_WAIT_L(0); PG8_MMA(1, 0, At, B0); PG8_BAR; PG8_SCHED;
            PG8_STAGE(PG8_SB(0, 1), b2 + hstep, voffB);
            PG8_WAIT_V(6); PG8_BAR; PG8_MMA(1, 1, At, B1); PG8_BAR;
            PG8_LDB(B0, 1, 0); PG8_SCHED; PG8_LDA(At, 1, 0); PG8_STAGE(PG8_SA(0, 1), a2 + hstep, voffA);
            PG8_WAIT_L(8); PG8_BAR; PG8_WAIT_L(0); PG8_MMA(0, 0, At, B0); PG8_BAR; PG8_SCHED;
            PG8_LDB(B1, 1, 1); PG8_STAGE(PG8_SB(1, 0), b3, voffB);
            PG8_BAR; PG8_WAIT_L(0); PG8_MMA(0, 1, At, B1); PG8_BAR;
            PG8_LDA(At, 1, 1); PG8_STAGE(PG8_SA(1, 0), a3, voffA);
            PG8_BAR; PG8_WAIT_L(0); PG8_MMA(1, 0, At, B0); PG8_BAR; PG8_SCHED;
            PG8_STAGE(PG8_SB(1, 1), b3 + hstep, voffB);
            PG8_WAIT_V(6); PG8_BAR; PG8_MMA(1, 1, At, B1); PG8_BAR;
            }
        }
        if constexpr (ALIGN_EPI) { if (wr == 0) PG8_BAR; }
        if constexpr (!Epi::AFTER_DRAIN) { E(acc, cur, wr, wc, fr, fq); S.done(cur); }
        if (!has_next) break;
#pragma unroll
        for (int a = 0; a < 2; ++a)
#pragma unroll
            for (int b = 0; b < 2; ++b)
#pragma unroll
                for (int m = 0; m < 4; ++m)
#pragma unroll
                    for (int n = 0; n < 2; ++n) acc[a][b][m][n] = (f32x4){0.f, 0.f, 0.f, 0.f};
        cur = nxt; cA = nA; cB = nB; ++ui;
        if constexpr (ALIGN_EPI) { if (wr == 1) PG8_BAR; }
    }
    PG8_WAIT_V(0);
    if constexpr (!ALIGN_EPI) { if (wr == 0) PG8_BAR; }
    PG8_BAR;
    if constexpr (Epi::AFTER_DRAIN) { E.fused(acc, cur, wr, wc, fr, fq, lds, wid, lane); S.done(cur); }
#undef PG8_SA
#undef PG8_SB
#undef PG8_STAGE
#undef PG8_LDA
#undef PG8_LDB
#undef PG8_MMA
#undef PG8_WAIT_V
#undef PG8_WAIT_L
#undef PG8_BAR
#undef PG8_SCHED
}
}

#include <hip/hip_cooperative_groups.h>
namespace cg = cooperative_groups;
#define LAS __attribute__((address_space(3)))
typedef unsigned short bf16;
typedef float f32x4 __attribute__((ext_vector_type(4)));
typedef float f32x16 __attribute__((ext_vector_type(16)));
typedef short bf16x8 __attribute__((ext_vector_type(8)));
typedef unsigned u32x4 __attribute__((ext_vector_type(4)));
typedef unsigned u32x2 __attribute__((ext_vector_type(2)));
typedef float f32x2 __attribute__((ext_vector_type(2)));
#define MFMA32(a, b, c) __builtin_amdgcn_mfma_f32_32x32x16_bf16((a), (b), (c), 0, 0, 0)

constexpr int T = 32768, TB = 16384, D = 1024, NIN = 8192, FF = 2816, PLE = 256, SGWD = 512;
constexpr int NSEG = 32, SEGCH = 8;
constexpr float EPS = 1e-6f;
constexpr size_t MiB = 1u << 20;
constexpr size_t WS_LBT = 0;
constexpr size_t WS_DSEG = 64 * 1024;
constexpr size_t WS_SGW = 1 * MiB;
constexpr size_t WS_W = 2 * MiB;
constexpr size_t W_IN = WS_W, W_A = WS_W + 16 * MiB, W_B = WS_W + 18 * MiB, W_O = WS_W + 19 * MiB, W_GU = WS_W + 21 * MiB,
                 W_DN = WS_W + 32 * MiB, W_PG = WS_W + 32 * MiB + 5632 * 1024, W_PL = W_PG + 2 * MiB;
constexpr size_t WS_H = 42 * MiB;
constexpr size_t WS_MIX = 74 * MiB;
constexpr size_t WS_R = 138 * MiB;
constexpr size_t WS_Q = WS_R, WS_LF = WS_R + 32 * MiB, WS_LB = WS_R + 64 * MiB, WS_V = WS_R + 96 * MiB, WS_ZG = WS_R + 128 * MiB,
                 WS_U = WS_R + 160 * MiB, WS_GV = WS_R + 176 * MiB, WS_SA = WS_R + 192 * MiB, WS_SB = WS_R + 224 * MiB,
                 WS_BO = WS_R + 256 * MiB, WS_AO = WS_R + 272 * MiB, WS_SEG = WS_R + 304 * MiB;
constexpr size_t WS_HID = WS_R, WS_H2 = WS_R + 176 * MiB, WS_PB = WS_R + 240 * MiB;
constexpr size_t WS_PB2 = WS_R + 336 * MiB;
constexpr size_t WS_END = WS_R + 352 * MiB;
static_assert(W_PL + 1024 * 256 * 2 <= WS_H, "weights map");

constexpr int LDS_BYTES = 143360;

__device__ __forceinline__ float bf2f(unsigned b) { return __uint_as_float(b << 16); }
__device__ __forceinline__ unsigned f2bf(float f) { unsigned u = __float_as_uint(f); return (u + 0x7fffu + ((u >> 16) & 1u)) >> 16; }
typedef __bf16 bf16x2_t __attribute__((ext_vector_type(2)));
__device__ __forceinline__ unsigned pk2(float lo, float hi) { f32x2 v = {lo, hi}; bf16x2_t b = __builtin_convertvector(v, bf16x2_t); return __builtin_bit_cast(unsigned, b); }
__device__ __forceinline__ float sigm(float x) { return __builtin_amdgcn_rcpf(1.f + __builtin_amdgcn_exp2f(-1.44269504089f * x)); }
__device__ __forceinline__ float siluf(float x) { return x * sigm(x); }
__device__ __forceinline__ float geluf(float v) {
    const float av = fabsf(v), d = av * 0.2316418882f + 1.0f; const float t = __builtin_amdgcn_rcpf(d);
    float q = t * 0.5307027145f + (-0.7265760135f); q = q * t + 0.7107068705f; q = q * t + (-0.142248368f); q = q * t + 0.127414796f; q = q * t;
    const float e = __builtin_amdgcn_exp2f((v * v) * (-0.72134752044f));
    const float m = v * (q * e); return v < 0.f ? m : v - m; }
__device__ __forceinline__ unsigned f2h(float x) { _Float16 h = (_Float16)x; return (unsigned)__builtin_bit_cast(unsigned short, h); }
__device__ __forceinline__ float h2f(unsigned short b) { return (float)__builtin_bit_cast(_Float16, b); }
__device__ __forceinline__ void st8bf(bf16* p, f32x4 lo, f32x4 hi) {
    u32x4 w; w.x = pk2(lo[0], lo[1]); w.y = pk2(lo[2], lo[3]); w.z = pk2(hi[0], hi[1]); w.w = pk2(hi[2], hi[3]); *(u32x4*)p = w; }
__device__ __forceinline__ void ld8bf(const bf16* p, f32x4& lo, f32x4& hi) {
    const u32x4 w = *(const u32x4*)p;
    lo[0] = __uint_as_float(w.x << 16); lo[1] = __uint_as_float(w.x & 0xffff0000u); lo[2] = __uint_as_float(w.y << 16); lo[3] = __uint_as_float(w.y & 0xffff0000u);
    hi[0] = __uint_as_float(w.z << 16); hi[1] = __uint_as_float(w.z & 0xffff0000u); hi[2] = __uint_as_float(w.w << 16); hi[3] = __uint_as_float(w.w & 0xffff0000u); }
template <int CTRL> __device__ __forceinline__ float dppf(float v) { return __int_as_float(__builtin_amdgcn_update_dpp(0, __float_as_int(v), CTRL, 0xf, 0xf, true)); }
__device__ __forceinline__ float row16_sum(float v) {
    v += dppf<0xB1>(v);
    v += dppf<0x4E>(v);
    v += dppf<0x141>(v);
    v += dppf<0x140>(v);
    return v;
}
__device__ __forceinline__ float wave_sum(float v) {
    v = row16_sum(v);
    v += __shfl_xor(v, 16); v += __shfl_xor(v, 32);
    return v;
}

template <class F> struct EpiRow8 {
    static constexpr bool PERM = true, AFTER_DRAIN = false;
    F f;
    __device__ __forceinline__ void operator()(const pg8::f32x4 (&acc)[2][2][4][2], const pg8::Unit& u, int wr, int wc, int fr, int fq) const {
        { int t_ = threadIdx.x; asm volatile("" : "+v"(t_)); const int w_ = __builtin_amdgcn_readfirstlane(t_ >> 6), l_ = t_ & 63; wr = w_ >> 2; wc = w_ & 3; fr = l_ & 15; fq = l_ >> 4; }
        unsigned char* w = f.ws; asm volatile("" : "+s"(w));
#pragma unroll
        for (int ai = 0; ai < 2; ++ai)
#pragma unroll
            for (int m = 0; m < 4; ++m) {
                const int row = u.pm * 256 + ai * 128 + wr * 64 + m * 16 + fr;
#pragma unroll
                for (int bj = 0; bj < 2; ++bj) {
                    const int col = u.pn * 256 + bj * 128 + wc * 32 + 8 * fq;
                    f(w, row, col, acc[ai][bj][m][0], acc[ai][bj][m][1]);
                }
            }
    }
};
struct EpiSwiglu {
    static constexpr bool PERM = true, AFTER_DRAIN = false;
    unsigned char* ws;
    __device__ __forceinline__ void operator()(const pg8::f32x4 (&acc)[2][2][4][2], const pg8::Unit& u, int wr, int wc, int fr, int fq) const {
        { int t_ = threadIdx.x; asm volatile("" : "+v"(t_)); const int w_ = __builtin_amdgcn_readfirstlane(t_ >> 6), l_ = t_ & 63; wr = w_ >> 2; wc = w_ & 3; fr = l_ & 15; fq = l_ >> 4; }
        unsigned char* w = ws; asm volatile("" : "+s"(w));
        bf16* HID = (bf16*)(w + WS_HID);
#pragma unroll
        for (int ai = 0; ai < 2; ++ai)
#pragma unroll
            for (int m = 0; m < 4; ++m) {
                const int row = u.pm * 256 + ai * 128 + wr * 64 + m * 16 + fr;
                const int hcol = u.pn * 128 + wc * 32 + 8 * fq;
                f32x4 lo, hi;
#pragma unroll
                for (int i = 0; i < 4; ++i) { lo[i] = siluf(acc[ai][0][m][0][i]) * acc[ai][1][m][0][i]; hi[i] = siluf(acc[ai][0][m][1][i]) * acc[ai][1][m][1][i]; }
                st8bf(HID + (size_t)row * FF + hcol, lo, hi);
            }
    }
};

struct EpiG1 {
    static constexpr bool PERM = true, AFTER_DRAIN = false;
    unsigned char* ws; int lb0;
    template <int KIND> __device__ __forceinline__ void seg(unsigned char* w, size_t dst, int ld, int cbase, const float* lb, const pg8::f32x4 (&acc)[2][2][4][2], const pg8::Unit& u, int wr, int wc, int fr, int fq) const {
#pragma unroll
        for (int ai = 0; ai < 2; ++ai)
#pragma unroll
            for (int m = 0; m < 4; ++m) {
                const int row = u.pm * 256 + ai * 128 + wr * 64 + m * 16 + fr;
#pragma unroll
                for (int bj = 0; bj < 2; ++bj) {
                    const int c = u.pn * 256 + bj * 128 + wc * 32 + 8 * fq - cbase;
                    f32x4 lo = acc[ai][bj][m][0], hi = acc[ai][bj][m][1];
                    if (KIND == 4) {
                        const f32x4 l0 = *(const f32x4*)(lb + c), l1 = *(const f32x4*)(lb + c + 4);
                        float r[8];
                        if (lb0) {
#pragma unroll
                            for (int i = 0; i < 4; ++i) {
                                r[i] = fmaxf(-__log2f(1.f + __builtin_amdgcn_exp2f(-1.44269504089f * lo[i])), -126.f);
                                r[4 + i] = fmaxf(-__log2f(1.f + __builtin_amdgcn_exp2f(-1.44269504089f * hi[i])), -126.f);
                            }
                        } else {
#pragma unroll
                        for (int i = 0; i < 4; ++i) {
                            const float f0 = l0[i] + (1.f - l0[i]) * sigm(lo[i]); r[i] = __log2f(fmaxf(f0, 1.17549435e-38f));
                            const float f1 = l1[i] + (1.f - l1[i]) * sigm(hi[i]); r[4 + i] = __log2f(fmaxf(f1, 1.17549435e-38f));
                        }
                        }
                        u32x4 v; v.x = f2h(r[0]) | (f2h(r[1]) << 16); v.y = f2h(r[2]) | (f2h(r[3]) << 16); v.z = f2h(r[4]) | (f2h(r[5]) << 16); v.w = f2h(r[6]) | (f2h(r[7]) << 16);
                        *(u32x4*)((unsigned short*)(w + dst) + (size_t)row * ld + c) = v;
                    } else {
#pragma unroll
                        for (int i = 0; i < 4; ++i) {
                            if (KIND == 1) { lo[i] = siluf(lo[i]); hi[i] = siluf(hi[i]); }
                            if (KIND == 2) { lo[i] = geluf(lo[i]); hi[i] = geluf(hi[i]); }
                            if (KIND == 3) { lo[i] = sigm(lo[i]); hi[i] = sigm(hi[i]); }
                        }
                        st8bf((bf16*)(w + dst) + (size_t)row * ld + c, lo, hi);
                    }
                }
            }
    }
    __device__ __forceinline__ void operator()(const pg8::f32x4 (&acc)[2][2][4][2], const pg8::Unit& u, int wr, int wc, int fr, int fq) const {
        { int t_ = threadIdx.x; asm volatile("" : "+v"(t_)); const int w_ = __builtin_amdgcn_readfirstlane(t_ >> 6), l_ = t_ & 63; wr = w_ >> 2; wc = w_ & 3; fr = l_ & 15; fq = l_ >> 4; }
        unsigned char* w = ws; asm volatile("" : "+s"(w));
        const int sg = u.pn >> 1;
        const float* lbt = (const float*)(w + WS_LBT);
        if (sg < 2) seg<1>(w, WS_Q, D, 0, nullptr, acc, u, wr, wc, fr, fq);
        else if (sg < 4) seg<4>(w, WS_LF, D, 1024, lbt, acc, u, wr, wc, fr, fq);
        else if (sg < 6) seg<4>(w, WS_LB, D, 2048, lbt + 1024, acc, u, wr, wc, fr, fq);
        else if (sg < 8) seg<0>(w, WS_V, D, 3072, nullptr, acc, u, wr, wc, fr, fq);
        else if (sg < 10) seg<1>(w, WS_ZG, D, 4096, nullptr, acc, u, wr, wc, fr, fq);
        else if (sg == 10) seg<2>(w, WS_U, SGWD, 5120, nullptr, acc, u, wr, wc, fr, fq);
        else if (sg == 11) seg<2>(w, WS_GV, SGWD, 5632, nullptr, acc, u, wr, wc, fr, fq);
        else if (sg < 14) seg<3>(w, WS_SA, D, 6144, nullptr, acc, u, wr, wc, fr, fq);
        else seg<3>(w, WS_SB, D, 7168, nullptr, acc, u, wr, wc, fr, fq);
    }
};
struct FG2 { unsigned char* ws;
    __device__ __forceinline__ void operator()(unsigned char* w, int row, int col, f32x4 lo, f32x4 hi) const {
        f32x4 a, b; ld8bf((const bf16*)(w + WS_SA) + (size_t)row * D + col, a, b); st8bf((bf16*)(w + WS_Q) + (size_t)row * D + col, lo * a, hi * b); } };
struct FG3 { unsigned char* ws;
    __device__ __forceinline__ void operator()(unsigned char* w, int row, int col, f32x4 lo, f32x4 hi) const {
        f32x4 a, b, c, d; ld8bf((const bf16*)(w + WS_SB) + (size_t)row * D + col, a, b); bf16* m1 = (bf16*)(w + WS_Q) + (size_t)row * D + col; ld8bf(m1, c, d); st8bf(m1, c + lo * a, d + hi * b); } };
struct FStore { unsigned char* ws; size_t off;
    __device__ __forceinline__ void operator()(unsigned char* w, int row, int col, f32x4 lo, f32x4 hi) const { st8bf((bf16*)(w + off) + (size_t)row * D + col, lo, hi); } };
struct FSig { unsigned char* ws;
    __device__ __forceinline__ void operator()(unsigned char* w, int row, int col, f32x4 lo, f32x4 hi) const {
#pragma unroll
        for (int i = 0; i < 4; ++i) { lo[i] = sigm(lo[i]); hi[i] = sigm(hi[i]); }
        st8bf((bf16*)(w + WS_MIX) + (size_t)row * D + col, lo, hi); } };
struct FG8 { unsigned char* ws; float* X;
    __device__ __forceinline__ void operator()(unsigned char* w, int row, int col, f32x4 lo, f32x4 hi) const {
        f32x4 a, b; ld8bf((const bf16*)(w + WS_MIX) + (size_t)row * D + col, a, b);
        float* xp = X + (size_t)row * D + col; const f32x4 x0 = *(const f32x4*)xp, x1 = *(const f32x4*)(xp + 4);
        *(f32x4*)xp = x0 + lo * a; *(f32x4*)(xp + 4) = x1 + hi * b; } };

template <class Epi, bool ALIGN = true> __device__ __forceinline__ void run_gemm(LAS unsigned char* lds, const bf16* A, const bf16* Bt, int M, int N, int K, const Epi& E, int tid, int bid) {
    pg8::Gemm g{A, Bt, M, N, K}; pg8::StaticOrder S; S.init(M, N, (int)gridDim.x, bid);
    pg8::gemm_phase<Epi, pg8::StaticOrder, ALIGN, true>(lds, g, S, E, tid);
}

__device__ __forceinline__ void transpose_item(const float* W, int K, int N, bf16* WT, int mode, LAS float* scr, int item, int lane) {
    const int nblk = N / 32, kb = item / nblk, nb = item % nblk, k0 = 64 * kb, n0 = 32 * nb;
    const int r0 = mode == 0 ? n0 : (256 * (n0 >> 7) + (n0 & 127) + (mode == 2 ? 128 : 0));
#pragma unroll 8
    for (int i = 0; i < 32; ++i) { const int kk = 2 * i + (lane >> 5); scr[kk * 33 + (lane & 31)] = W[(size_t)(k0 + kk) * N + n0 + (lane & 31)]; }
    asm volatile("s_waitcnt lgkmcnt(0)" ::: "memory");
    const int c = lane & 7;
#pragma unroll
    for (int j = 0; j < 4; ++j) { const int n = (lane >> 3) + 8 * j; const LAS float* s = scr + (8 * c) * 33 + n;
        u32x4 o; o.x = pk2(s[0 * 33], s[1 * 33]); o.y = pk2(s[2 * 33], s[3 * 33]); o.z = pk2(s[4 * 33], s[5 * 33]); o.w = pk2(s[6 * 33], s[7 * 33]);
        *(u32x4*)(WT + (size_t)(r0 + n) * K + k0 + 8 * c) = o; }
    asm volatile("s_waitcnt lgkmcnt(0)" ::: "memory");
}

struct Args { const float* in[22]; float* out; unsigned char* ws; int ph_lo, ph_hi; };

__device__ __forceinline__ void prologue(const __attribute__((address_space(4))) Args* a, unsigned char* ws, int l, LAS unsigned char* lds, int tid, int wave, int lane) {
    LAS float* scr = (LAS float*)(lds + wave * 16384);
    const int gw = blockIdx.x * 8 + wave, NGW = gridDim.x * 8;
    constexpr int I_IN = 16 * 256, I_A = 16 * 32, I_B = 8 * 32, I_O = 16 * 32, I_G = 16 * 88, I_D = 44 * 32, I_PG = 16 * 32, I_PL = 4 * 32;
    constexpr int NIT = I_IN + I_A + I_B + I_O + 2 * I_G + I_D + I_PG + I_PL;
    for (int it = gw; it < NIT; it += NGW) {
        int r = it;
        if (r < I_IN) { transpose_item(a->in[3] + (size_t)l * D * NIN, D, NIN, (bf16*)(ws + W_IN), 0, scr, r, lane); continue; } r -= I_IN;
        if (r < I_A) { transpose_item(a->in[11] + (size_t)l * D * D, D, D, (bf16*)(ws + W_A), 0, scr, r, lane); continue; } r -= I_A;
        if (r < I_B) { transpose_item(a->in[12] + (size_t)l * SGWD * D, SGWD, D, (bf16*)(ws + W_B), 0, scr, r, lane); continue; } r -= I_B;
        if (r < I_O) { transpose_item(a->in[13] + (size_t)l * D * D, D, D, (bf16*)(ws + W_O), 0, scr, r, lane); continue; } r -= I_O;
        if (r < I_G) { transpose_item(a->in[16] + (size_t)l * D * FF, D, FF, (bf16*)(ws + W_GU), 1, scr, r, lane); continue; } r -= I_G;
        if (r < I_G) { transpose_item(a->in[17] + (size_t)l * D * FF, D, FF, (bf16*)(ws + W_GU), 2, scr, r, lane); continue; } r -= I_G;
        if (r < I_D) { transpose_item(a->in[18] + (size_t)l * FF * D, FF, D, (bf16*)(ws + W_DN), 0, scr, r, lane); continue; } r -= I_D;
        if (r < I_PG) { transpose_item(a->in[21] + (size_t)l * D * D, D, D, (bf16*)(ws + W_PG), 0, scr, r, lane); continue; } r -= I_PG;
        transpose_item(a->in[20] + (size_t)l * PLE * D, PLE, D, (bf16*)(ws + W_PL), 0, scr, r, lane);
    }
    const int gt = blockIdx.x * 512 + tid, NGT = gridDim.x * 512;
    for (int i = gt; i < 2048; i += NGT) {
        const float* gm = a->in[i < 1024 ? 4 : 5]; const int c = i & 1023;
        ((float*)(ws + WS_LBT))[i] = (l == 0) ? 0.f : 1.f / (1.f + __expf(gm[c] - gm[1024 + c]));
    }
    for (int i = gt; i < 8 * 128 * 128 / 2; i += NGT) {
        const float* s = a->in[7] + (size_t)l * 131072 + 2 * i;
        ((unsigned*)(ws + WS_SGW))[i] = pk2(s[0], s[1]);
    }
}

__device__ __forceinline__ void ldrow8(const float* p, f32x4& a, f32x4& b) { a = *(const f32x4*)p; b = *(const f32x4*)(p + 4); }
__device__ __forceinline__ float sq8(const f32x4& a, const f32x4& b) { return (a[0] * a[0] + a[1] * a[1]) + (a[2] * a[2] + a[3] * a[3]) + (b[0] * b[0] + b[1] * b[1]) + (b[2] * b[2] + b[3] * b[3]); }
__device__ __forceinline__ void rows_r0(const float* xin, const float* g, bf16* H, int row0, int nrows, int wave, int lane) {
    const int gw = blockIdx.x * 8 + wave, NGW = gridDim.x * 8;
    f32x4 ga[2], gb[2];
#pragma unroll
    for (int j = 0; j < 2; ++j) ldrow8(g + 8 * lane + 512 * j, ga[j], gb[j]);
    for (int m = gw; m < nrows; m += NGW) {
        const float* xr = xin + (size_t)(row0 + m) * D + 8 * lane; f32x4 va[2], vb[2]; float s = 0.f;
#pragma unroll
        for (int j = 0; j < 2; ++j) { ldrow8(xr + 512 * j, va[j], vb[j]); s += sq8(va[j], vb[j]); }
        const float r = rsqrtf(wave_sum(s) * (1.f / D) + EPS);
        bf16* o = H + (size_t)m * D + 8 * lane;
#pragma unroll
        for (int j = 0; j < 2; ++j) st8bf(o + 512 * j, va[j] * r * ga[j], vb[j] * r * gb[j]);
    }
}
__device__ __forceinline__ void rows_r12(const float* xin, float* xout, const bf16* Y, const float* g1, const float* g2, bf16* Hout, const float* prow, bf16* PB, int wave, int lane) {
    const int gw = blockIdx.x * 8 + wave, NGW = gridDim.x * 8;
    for (int m = gw; m < T; m += NGW) {
        const float* xr = xin + (size_t)m * D + 8 * lane; const bf16* yr = Y + (size_t)m * D + 8 * lane;
        f32x4 va[2], vb[2], ya[2], yb[2]; float s = 0.f;
#pragma unroll
        for (int j = 0; j < 2; ++j) { ldrow8(xr + 512 * j, va[j], vb[j]); ld8bf(yr + 512 * j, ya[j], yb[j]); s += sq8(ya[j], yb[j]); }
        f32x4 pv; if (prow) pv = *(const f32x4*)(prow + (size_t)m * PLE + 4 * lane);
        const float r = rsqrtf(wave_sum(s) * (1.f / D) + EPS);
        float s2 = 0.f;
#pragma unroll
        for (int j = 0; j < 2; ++j) { f32x4 ga, gb; ldrow8(g1 + 8 * lane + 512 * j, ga, gb); va[j] = va[j] + ya[j] * r * ga; vb[j] = vb[j] + yb[j] * r * gb;
            float* xo = xout + (size_t)m * D + 8 * lane + 512 * j; *(f32x4*)xo = va[j]; *(f32x4*)(xo + 4) = vb[j];
            s2 += sq8(va[j], vb[j]); }
        bf16* o = Hout + (size_t)m * D + 8 * lane;
        if (g2) {
            const float r2 = rsqrtf(wave_sum(s2) * (1.f / D) + EPS);
#pragma unroll
            for (int j = 0; j < 2; ++j) { f32x4 ga, gb; ldrow8(g2 + 8 * lane + 512 * j, ga, gb); st8bf(o + 512 * j, va[j] * r2 * ga, vb[j] * r2 * gb); }
        } else {
#pragma unroll
            for (int j = 0; j < 2; ++j) st8bf(o + 512 * j, va[j], vb[j]);
        }
        if (prow) { u32x2 w; w.x = pk2(pv[0], pv[1]); w.y = pk2(pv[2], pv[3]); *(u32x2*)(PB + (size_t)m * PLE + 4 * lane) = w; }
    }
}

constexpr int LDQ = 136, LDT = 72, LDSTG = 132;
constexpr int L_QD = 0, L_QS = 17408, L_KS = 34816, L_KDT = 52224, L_VT = 70656, L_ST = 89088, L_P = 123904, L_TOT = 133120, L_DV = 137216, L_RS = 137728;
static_assert(L_RS + 1024 <= LDS_BYTES - 16 && 64 * LDSTG * 4 <= L_KDT - L_QS, "lds map");
__device__ __forceinline__ int rowf(int reg, int hh) { return (reg & 3) + 8 * (reg >> 2) + 4 * hh; }

#define LBAR() asm volatile("s_waitcnt lgkmcnt(0)\n\ts_barrier" ::: "memory")
template <bool OUT>
__device__ __forceinline__ void scan_item(LAS unsigned char* lds, unsigned char* ws, const float* hgn_l, int item, int tid_in, int wid, int lane_in) {
    const int h = item / NSEG, seg = item % NSEG;
    float* SEG = (float*)(ws + WS_SEG); float* DSEG = (float*)(ws + WS_DSEG);
    const bf16* Qp = (const bf16*)(ws + WS_Q); const bf16* Vp = (const bf16*)(ws + WS_V); bf16* AOp = (bf16*)(ws + WS_AO); const bf16* ZGp = (const bf16*)(ws + WS_ZG);
    LAS unsigned short* QD = (LAS unsigned short*)(lds + L_QD); LAS unsigned short* QS = (LAS unsigned short*)(lds + L_QS); LAS unsigned short* KS = (LAS unsigned short*)(lds + L_KS);
    LAS float* TOT = (LAS float*)(lds + L_TOT); LAS float* DV = (LAS float*)(lds + L_DV); LAS float* RS = (LAS float*)(lds + L_RS);
    for (int dir = 0; dir < 2; ++dir) {
        if (OUT && dir == 1) __syncthreads();
        int tid = tid_in, lane = lane_in;
        asm volatile("" : "+v"(tid), "+v"(lane));
        f32x16 S[2];
        bf16* spb = (bf16*)SEG + (size_t)((h * 2 + dir) * NSEG + seg) * 16384;
        {
            const int r = lane & 31, hh = lane >> 5, kb = wid >> 1;
#pragma unroll
            for (int j = 0; j < 2; ++j) { const int vc = (2 * (wid & 1) + j) * 32 + r;
#pragma unroll
                for (int g = 0; g < 4; ++g) {
                    if (OUT) { const u32x2 w = *(const u32x2*)(spb + vc * 128 + kb * 32 + 8 * g + 4 * hh);
                        S[j][4 * g] = __uint_as_float(w.x << 16); S[j][4 * g + 1] = __uint_as_float(w.x & 0xffff0000u); S[j][4 * g + 2] = __uint_as_float(w.y << 16); S[j][4 * g + 3] = __uint_as_float(w.y & 0xffff0000u); }
                    else { S[j][4 * g] = 0.f; S[j][4 * g + 1] = 0.f; S[j][4 * g + 2] = 0.f; S[j][4 * g + 3] = 0.f; } } }
        }
        const unsigned short* LFp = (const unsigned short*)(ws + (dir ? WS_LB : WS_LF));
        unsigned lraw[8], vraw[8], qraw[8];
        float dsa = 0.f, dsb = 0.f;
        const int es = dir ? -D : D;
        {
            const int c = seg * SEGCH + (dir ? SEGCH - 1 : 0);
            const unsigned e0 = (unsigned)((c * 64 + (dir ? 63 - wid * 8 : wid * 8)) * D + h * 128 + 2 * lane);
#pragma unroll
            for (int i = 0; i < 8; ++i) lraw[i] = *(const unsigned*)(LFp + (e0 + (unsigned)(i * es)));
#pragma unroll
            for (int i = 0; i < 8; ++i) vraw[i] = *(const unsigned*)(Vp + (e0 + (unsigned)(i * es)));
            if (OUT) {
#pragma unroll
                for (int i = 0; i < 8; ++i) qraw[i] = *(const unsigned*)(Qp + (e0 + (unsigned)(i * es)));
            }
        }
        for (int ci = 0; ci < SEGCH; ++ci) {
            asm volatile("" : "+v"(tid), "+v"(lane));
            const int r = lane & 31, hh = lane >> 5;
            const int c = seg * SEGCH + (dir ? SEGCH - 1 - ci : ci), tok0 = c * 64;
            if (OUT) {
                const int kb = wid >> 1;
#pragma unroll
                for (int j = 0; j < 2; ++j) { const int vcol = (2 * (wid & 1) + j) * 32 + r;
#pragma unroll
                    for (int g = 0; g < 4; ++g) { u32x2 w; w.x = pk2(S[j][4 * g], S[j][4 * g + 1]); w.y = pk2(S[j][4 * g + 2], S[j][4 * g + 3]);
                        *(LAS u32x2*)(lds + L_ST + (vcol * LDQ + kb * 32 + 8 * g + 4 * hh) * 2) = w; } }
            }
            float bla[8], blb[8], lfa[8], lfb[8]; float runa = 0.f, runb = 0.f;
#pragma unroll
            for (int i = 0; i < 8; ++i) { lfa[i] = h2f((unsigned short)(lraw[i] & 0xffffu)); lfb[i] = h2f((unsigned short)(lraw[i] >> 16)); runa += lfa[i]; runb += lfb[i]; bla[i] = runa; blb[i] = runb; }
            *(LAS f32x2*)(TOT + wid * 128 + 2 * lane) = (f32x2){runa, runb};
            LBAR();
            float offa = 0.f, offb = 0.f, bma = 0.f, bmb = 0.f, bta = 0.f, btb = 0.f;
#pragma unroll
            for (int p = 0; p < 8; ++p) { const f32x2 t = *(const LAS f32x2*)(TOT + p * 128 + 2 * lane);
                if (p < wid) { offa += t[0]; offb += t[1]; } if (p < 4) { bma += t[0]; bmb += t[1]; } bta += t[0]; btb += t[1]; }
            const float c1a = __builtin_amdgcn_exp2f(bta - bma), c1b = __builtin_amdgcn_exp2f(btb - bmb), c2a = __builtin_amdgcn_exp2f(bma), c2b = __builtin_amdgcn_exp2f(bmb);
            float kda[8], kdb[8];
#pragma unroll
            for (int i = 0; i < 8; ++i) {
                const float ba = bla[i] + offa, bb = blb[i] + offb;
                const float kka = 1.f - __builtin_amdgcn_exp2f(lfa[i]), kkb = 1.f - __builtin_amdgcn_exp2f(lfb[i]);
                if (OUT) {
                    const int tau = wid * 8 + i;
                    const float qa = __uint_as_float(qraw[i] << 16), qb = __uint_as_float(qraw[i] & 0xffff0000u);
                    const float qsa = qa * __builtin_amdgcn_exp2f(fminf(ba - bma, 115.f)), qsb = qb * __builtin_amdgcn_exp2f(fminf(bb - bmb, 115.f));
                    const float ksa = kka * __builtin_amdgcn_exp2f(fminf(bma - ba, 115.f)), ksb = kkb * __builtin_amdgcn_exp2f(fminf(bmb - bb, 115.f));
                    kda[i] = ksa * c1a; kdb[i] = ksb * c1b;
                    *(LAS unsigned*)(lds + L_QD + (tau * LDQ + 2 * lane) * 2) = pk2(qsa * c2a, qsb * c2b);
                    *(LAS unsigned*)(lds + L_QS + (tau * LDQ + 2 * lane) * 2) = pk2(qsa, qsb);
                    *(LAS unsigned*)(lds + L_KS + (tau * LDQ + 2 * lane) * 2) = pk2(ksa, ksb);
                } else {
                    kda[i] = kka * __builtin_amdgcn_exp2f(bta - ba); kdb[i] = kkb * __builtin_amdgcn_exp2f(btb - bb);
                }
            }
            {
                LAS u32x4* kp = (LAS u32x4*)(lds + L_KDT + ((2 * lane) * LDT + wid * 8) * 2); LAS u32x4* vp = (LAS u32x4*)(lds + L_VT + ((2 * lane) * LDT + wid * 8) * 2);
                kp[0] = (u32x4){pk2(kda[0], kda[1]), pk2(kda[2], kda[3]), pk2(kda[4], kda[5]), pk2(kda[6], kda[7])};
                kp[LDT * 2 / 16] = (u32x4){pk2(kdb[0], kdb[1]), pk2(kdb[2], kdb[3]), pk2(kdb[4], kdb[5]), pk2(kdb[6], kdb[7])};
                u32x4 va, vb;
#pragma unroll
                for (int j = 0; j < 4; ++j) { va[j] = (vraw[2 * j] & 0xffffu) | (vraw[2 * j + 1] << 16); vb[j] = (vraw[2 * j] >> 16) | (vraw[2 * j + 1] & 0xffff0000u); }
                vp[0] = va; vp[LDT * 2 / 16] = vb;
            }
            if (wid == 0) { *(LAS f32x2*)(DV + 2 * lane) = (f32x2){__builtin_amdgcn_exp2f(bta), __builtin_amdgcn_exp2f(btb)}; dsa += bta; dsb += btb; }
            if (ci + 1 < SEGCH) {
                const int cn = seg * SEGCH + (dir ? SEGCH - 2 - ci : ci + 1);
                const unsigned e0 = (unsigned)((cn * 64 + (dir ? 63 - wid * 8 : wid * 8)) * D + h * 128 + 2 * lane);
#pragma unroll
                for (int i = 0; i < 8; ++i) lraw[i] = *(const unsigned*)(LFp + (e0 + (unsigned)(i * es)));
#pragma unroll
                for (int i = 0; i < 8; ++i) vraw[i] = *(const unsigned*)(Vp + (e0 + (unsigned)(i * es)));
                if (OUT) {
#pragma unroll
                    for (int i = 0; i < 8; ++i) qraw[i] = *(const unsigned*)(Qp + (e0 + (unsigned)(i * es)));
                }
            }
            u32x4 aoraw[2], zgraw[2];
            const int otb = wid >> 2, ovb = wid & 3, ovc = ovb * 32 + r;
            const int ftau = tid >> 4, fv0 = 8 * (tid & 15);
            if (OUT && dir == 1) {
#pragma unroll
                for (int j = 0; j < 2; ++j) { const unsigned ad = (unsigned)((tok0 + 63 - (ftau + 32 * j)) * D + h * 128 + fv0); aoraw[j] = *(const u32x4*)(AOp + ad); zgraw[j] = *(const u32x4*)(ZGp + ad); }
            }
            LBAR();
            if (OUT) {
                if (wid < 4) {
                    const int tb = wid >> 1, sb = wid & 1;
                    f32x16 p;
#pragma unroll
                    for (int i = 0; i < 16; ++i) p[i] = 0.f;
                    if (!(tb == 0 && sb == 1)) {
#pragma unroll
                        for (int kk = 0; kk < 8; ++kk) {
                            const bf16x8 a = *(const LAS bf16x8*)(lds + L_QS + ((tb * 32 + r) * LDQ + kk * 16 + 8 * hh) * 2);
                            const bf16x8 b = *(const LAS bf16x8*)(lds + L_KS + ((sb * 32 + r) * LDQ + kk * 16 + 8 * hh) * 2);
                            p = MFMA32(a, b, p);
                        }
                    }
                    LAS unsigned short* P = (LAS unsigned short*)(lds + L_P);
#pragma unroll
                    for (int i = 0; i < 16; ++i) { const int row = tb * 32 + rowf(i, hh), col = sb * 32 + r; P[row * LDT + col] = (unsigned short)f2bf(col <= row ? p[i] : 0.f); }
                }
                else {
                const int kb = wid >> 1;
#pragma unroll
                for (int j = 0; j < 2; ++j) {
                    const int vb = 2 * (wid & 1) + j;
#pragma unroll
                    for (int i = 0; i < 16; ++i) S[j][i] *= DV[kb * 32 + rowf(i, hh)];
#pragma unroll
                    for (int kk = 0; kk < 4; ++kk) {
                        const bf16x8 a = *(const LAS bf16x8*)(lds + L_KDT + ((kb * 32 + r) * LDT + kk * 16 + 8 * hh) * 2);
                        const bf16x8 b = *(const LAS bf16x8*)(lds + L_VT + ((vb * 32 + r) * LDT + kk * 16 + 8 * hh) * 2);
                        S[j] = MFMA32(a, b, S[j]);
                    }
                }
            }
                LBAR();
            }
            f32x16 o;
            if (OUT) {
#pragma unroll
                for (int i = 0; i < 16; ++i) o[i] = 0.f;
#pragma unroll
                for (int kk = 0; kk < 8; ++kk) {
                    const bf16x8 a = *(const LAS bf16x8*)(lds + L_QD + ((otb * 32 + r) * LDQ + kk * 16 + 8 * hh) * 2);
                    const bf16x8 b = *(const LAS bf16x8*)(lds + L_ST + ((ovb * 32 + r) * LDQ + kk * 16 + 8 * hh) * 2);
                    o = MFMA32(a, b, o);
                }
#pragma unroll
                for (int kk = 0; kk < 4; ++kk) {
                    const bf16x8 a = *(const LAS bf16x8*)(lds + L_P + ((otb * 32 + r) * LDT + kk * 16 + 8 * hh) * 2);
                    const bf16x8 b = *(const LAS bf16x8*)(lds + L_VT + ((ovb * 32 + r) * LDT + kk * 16 + 8 * hh) * 2);
                    o = MFMA32(a, b, o);
                }
            }
            if (!OUT || wid < 4) {
                const int kb = wid >> 1;
#pragma unroll
                for (int j = 0; j < 2; ++j) {
                    const int vb = 2 * (wid & 1) + j;
#pragma unroll
                    for (int i = 0; i < 16; ++i) S[j][i] *= DV[kb * 32 + rowf(i, hh)];
#pragma unroll
                    for (int kk = 0; kk < 4; ++kk) {
                        const bf16x8 a = *(const LAS bf16x8*)(lds + L_KDT + ((kb * 32 + r) * LDT + kk * 16 + 8 * hh) * 2);
                        const bf16x8 b = *(const LAS bf16x8*)(lds + L_VT + ((vb * 32 + r) * LDT + kk * 16 + 8 * hh) * 2);
                        S[j] = MFMA32(a, b, S[j]);
                    }
                }
            }
            if (OUT) {
                LAS float* STG = (LAS float*)(lds + L_QS);
#pragma unroll
                for (int i = 0; i < 16; ++i) STG[(otb * 32 + rowf(i, hh)) * LDSTG + ovc] = o[i];
                LBAR();
#pragma unroll
                for (int j = 0; j < 2; ++j) {
                    const int tau = ftau + 32 * j;
                    f32x4 a = *(const LAS f32x4*)(STG + tau * LDSTG + fv0), b = *(const LAS f32x4*)(STG + tau * LDSTG + fv0 + 4);
                    if (dir == 0) {
                        st8bf(AOp + (unsigned)((tok0 + tau) * D + h * 128 + fv0), a, b);
                    } else {
                        f32x4 fa, fb, za, zb;
                        { const u32x4 w = aoraw[j];
                          fa[0] = __uint_as_float(w.x << 16); fa[1] = __uint_as_float(w.x & 0xffff0000u); fa[2] = __uint_as_float(w.y << 16); fa[3] = __uint_as_float(w.y & 0xffff0000u);
                          fb[0] = __uint_as_float(w.z << 16); fb[1] = __uint_as_float(w.z & 0xffff0000u); fb[2] = __uint_as_float(w.w << 16); fb[3] = __uint_as_float(w.w & 0xffff0000u); }
                        { const u32x4 w = zgraw[j];
                          za[0] = __uint_as_float(w.x << 16); za[1] = __uint_as_float(w.x & 0xffff0000u); za[2] = __uint_as_float(w.y << 16); za[3] = __uint_as_float(w.y & 0xffff0000u);
                          zb[0] = __uint_as_float(w.z << 16); zb[1] = __uint_as_float(w.z & 0xffff0000u); zb[2] = __uint_as_float(w.w << 16); zb[3] = __uint_as_float(w.w & 0xffff0000u); }
                        a = a + fa; b = b + fb;
                        float ss = (a[0] * a[0] + a[1] * a[1]) + (a[2] * a[2] + a[3] * a[3]) + (b[0] * b[0] + b[1] * b[1]) + (b[2] * b[2] + b[3] * b[3]);
                        ss = row16_sum(ss);
                        const float rstd = rsqrtf(ss * (1.f / 128.f) + EPS);
                        const f32x4 g0 = *(const f32x4*)(hgn_l + h * 128 + fv0), g1 = *(const f32x4*)(hgn_l + h * 128 + fv0 + 4);
                        st8bf(AOp + (unsigned)((tok0 + 63 - tau) * D + h * 128 + fv0), a * rstd * g0 * za, b * rstd * g1 * zb);
                    }
                }
            }
            LBAR();
        }
        if (!OUT) {
            const int r = lane & 31, hh = lane >> 5, kb = wid >> 1;
#pragma unroll
            for (int j = 0; j < 2; ++j) { const int vc = (2 * (wid & 1) + j) * 32 + r;
#pragma unroll
                for (int g = 0; g < 4; ++g) { u32x2 w; w.x = pk2(S[j][4 * g], S[j][4 * g + 1]); w.y = pk2(S[j][4 * g + 2], S[j][4 * g + 3]);
                    *(u32x2*)(spb + vc * 128 + kb * 32 + 8 * g + 4 * hh) = w; } }
            if (wid == 0) *(f32x2*)(DSEG + ((h * 2 + dir) * NSEG + seg) * 128 + 2 * lane) = (f32x2){__builtin_amdgcn_exp2f(dsa), __builtin_amdgcn_exp2f(dsb)};
        }
    }
}

__device__ __forceinline__ void scan_p1_item(LAS unsigned char* lds, unsigned char* ws, int item, int tid_in, int wid, int lane_in) {
    const int h = item / NSEG, seg = item % NSEG;
    float* SEG = (float*)(ws + WS_SEG); float* DSEG = (float*)(ws + WS_DSEG);
    const unsigned short* LFp = (const unsigned short*)(ws + WS_LF); const unsigned short* LBp = (const unsigned short*)(ws + WS_LB); const bf16* Vp = (const bf16*)(ws + WS_V);
    constexpr int P_KF = 0, P_KB = 18432, P_VT = 36864, P_TOT = 55296, P_DV = 63488;
    LAS float* TOT = (LAS float*)(lds + P_TOT); LAS float* DV = (LAS float*)(lds + P_DV);
    int tid = tid_in, lane = lane_in;
    asm volatile("" : "+v"(tid), "+v"(lane));
    f32x16 Sf[2], Sb[2];
#pragma unroll
    for (int j = 0; j < 2; ++j)
#pragma unroll
        for (int i = 0; i < 16; ++i) { Sf[j][i] = 0.f; Sb[j][i] = 0.f; }
    float dsfa = 0.f, dsfb = 0.f, pba = 0.f, pbb = 0.f;
    unsigned lraw[8], braw[8], vraw[8];
    {
        const unsigned e0 = (unsigned)(((seg * SEGCH) * 64 + wid * 8) * D + h * 128 + 2 * lane);
#pragma unroll
        for (int i = 0; i < 8; ++i) lraw[i] = *(const unsigned*)(LFp + (e0 + (unsigned)(i * D)));
#pragma unroll
        for (int i = 0; i < 8; ++i) braw[i] = *(const unsigned*)(LBp + (e0 + (unsigned)(i * D)));
#pragma unroll
        for (int i = 0; i < 8; ++i) vraw[i] = *(const unsigned*)(Vp + (e0 + (unsigned)(i * D)));
    }
    for (int ci = 0; ci < SEGCH; ++ci) {
        asm volatile("" : "+v"(tid), "+v"(lane));
        const int r = lane & 31, hh = lane >> 5;
        float blfa[8], blfb[8], lfa[8], lfb[8], blba[8], blbb[8], lba[8], lbb[8]; float rfa = 0.f, rfb = 0.f, rba = 0.f, rbb = 0.f;
#pragma unroll
        for (int i = 0; i < 8; ++i) {
            lfa[i] = h2f((unsigned short)(lraw[i] & 0xffffu)); lfb[i] = h2f((unsigned short)(lraw[i] >> 16)); rfa += lfa[i]; rfb += lfb[i]; blfa[i] = rfa; blfb[i] = rfb;
            lba[i] = h2f((unsigned short)(braw[i] & 0xffffu)); lbb[i] = h2f((unsigned short)(braw[i] >> 16)); blba[i] = rba; blbb[i] = rbb; rba += lba[i]; rbb += lbb[i];
        }
        *(LAS f32x2*)(TOT + wid * 128 + 2 * lane) = (f32x2){rfa, rfb};
        *(LAS f32x2*)(TOT + (8 + wid) * 128 + 2 * lane) = (f32x2){rba, rbb};
        LBAR();
        float offa = 0.f, offb = 0.f, bta = 0.f, btb = 0.f, oba = 0.f, obb = 0.f, tba = 0.f, tbb = 0.f;
#pragma unroll
        for (int p = 0; p < 8; ++p) { const f32x2 t = *(const LAS f32x2*)(TOT + p * 128 + 2 * lane), u = *(const LAS f32x2*)(TOT + (8 + p) * 128 + 2 * lane);
            if (p < wid) { offa += t[0]; offb += t[1]; oba += u[0]; obb += u[1]; } bta += t[0]; btb += t[1]; tba += u[0]; tbb += u[1]; }
        float kfa[8], kfb[8], kba[8], kbb[8];
#pragma unroll
        for (int i = 0; i < 8; ++i) {
            kfa[i] = (1.f - __builtin_amdgcn_exp2f(lfa[i])) * __builtin_amdgcn_exp2f(bta - (blfa[i] + offa));
            kfb[i] = (1.f - __builtin_amdgcn_exp2f(lfb[i])) * __builtin_amdgcn_exp2f(btb - (blfb[i] + offb));
            kba[i] = (1.f - __builtin_amdgcn_exp2f(lba[i])) * __builtin_amdgcn_exp2f(pba + oba + blba[i]);
            kbb[i] = (1.f - __builtin_amdgcn_exp2f(lbb[i])) * __builtin_amdgcn_exp2f(pbb + obb + blbb[i]);
        }
        {
            LAS u32x4* kf = (LAS u32x4*)(lds + P_KF + ((2 * lane) * LDT + wid * 8) * 2); LAS u32x4* kb_ = (LAS u32x4*)(lds + P_KB + ((2 * lane) * LDT + wid * 8) * 2); LAS u32x4* vp = (LAS u32x4*)(lds + P_VT + ((2 * lane) * LDT + wid * 8) * 2);
            kf[0] = (u32x4){pk2(kfa[0], kfa[1]), pk2(kfa[2], kfa[3]), pk2(kfa[4], kfa[5]), pk2(kfa[6], kfa[7])};
            kf[LDT * 2 / 16] = (u32x4){pk2(kfb[0], kfb[1]), pk2(kfb[2], kfb[3]), pk2(kfb[4], kfb[5]), pk2(kfb[6], kfb[7])};
            kb_[0] = (u32x4){pk2(kba[0], kba[1]), pk2(kba[2], kba[3]), pk2(kba[4], kba[5]), pk2(kba[6], kba[7])};
            kb_[LDT * 2 / 16] = (u32x4){pk2(kbb[0], kbb[1]), pk2(kbb[2], kbb[3]), pk2(kbb[4], kbb[5]), pk2(kbb[6], kbb[7])};
            u32x4 va, vb;
#pragma unroll
            for (int j = 0; j < 4; ++j) { va[j] = (vraw[2 * j] & 0xffffu) | (vraw[2 * j + 1] << 16); vb[j] = (vraw[2 * j] >> 16) | (vraw[2 * j + 1] & 0xffff0000u); }
            vp[0] = va; vp[LDT * 2 / 16] = vb;
        }
        if (wid == 0) { *(LAS f32x2*)(DV + 2 * lane) = (f32x2){__builtin_amdgcn_exp2f(bta), __builtin_amdgcn_exp2f(btb)}; dsfa += bta; dsfb += btb; }
        pba += tba; pbb += tbb;
        if (ci + 1 < SEGCH) {
            const unsigned e0 = (unsigned)(((seg * SEGCH + ci + 1) * 64 + wid * 8) * D + h * 128 + 2 * lane);
#pragma unroll
            for (int i = 0; i < 8; ++i) lraw[i] = *(const unsigned*)(LFp + (e0 + (unsigned)(i * D)));
#pragma unroll
            for (int i = 0; i < 8; ++i) braw[i] = *(const unsigned*)(LBp + (e0 + (unsigned)(i * D)));
#pragma unroll
            for (int i = 0; i < 8; ++i) vraw[i] = *(const unsigned*)(Vp + (e0 + (unsigned)(i * D)));
        }
        LBAR();
        {
            const int kb = wid >> 1;
#pragma unroll
            for (int j = 0; j < 2; ++j) {
                const int vb = 2 * (wid & 1) + j;
#pragma unroll
                for (int i = 0; i < 16; ++i) Sf[j][i] *= DV[kb * 32 + rowf(i, hh)];
#pragma unroll
                for (int kk = 0; kk < 4; ++kk) {
                    const bf16x8 b = *(const LAS bf16x8*)(lds + P_VT + ((vb * 32 + r) * LDT + kk * 16 + 8 * hh) * 2);
                    const bf16x8 af = *(const LAS bf16x8*)(lds + P_KF + ((kb * 32 + r) * LDT + kk * 16 + 8 * hh) * 2);
                    const bf16x8 ab = *(const LAS bf16x8*)(lds + P_KB + ((kb * 32 + r) * LDT + kk * 16 + 8 * hh) * 2);
                    Sf[j] = MFMA32(af, b, Sf[j]); Sb[j] = MFMA32(ab, b, Sb[j]);
                }
            }
        }
        LBAR();
    }
    {
        const int r = lane & 31, hh = lane >> 5, kb = wid >> 1;
        bf16* spf = (bf16*)SEG + (size_t)((h * 2 + 0) * NSEG + seg) * 16384; bf16* spb = (bf16*)SEG + (size_t)((h * 2 + 1) * NSEG + seg) * 16384;
#pragma unroll
        for (int j = 0; j < 2; ++j) { const int vc = (2 * (wid & 1) + j) * 32 + r;
#pragma unroll
            for (int g = 0; g < 4; ++g) { const int o = vc * 128 + kb * 32 + 8 * g + 4 * hh; u32x2 wf, wb;
                wf.x = pk2(Sf[j][4 * g], Sf[j][4 * g + 1]); wf.y = pk2(Sf[j][4 * g + 2], Sf[j][4 * g + 3]); wb.x = pk2(Sb[j][4 * g], Sb[j][4 * g + 1]); wb.y = pk2(Sb[j][4 * g + 2], Sb[j][4 * g + 3]);
                *(u32x2*)(spf + o) = wf; *(u32x2*)(spb + o) = wb; } }
        if (wid == 0) {
            *(f32x2*)(DSEG + ((h * 2 + 0) * NSEG + seg) * 128 + 2 * lane) = (f32x2){__builtin_amdgcn_exp2f(dsfa), __builtin_amdgcn_exp2f(dsfb)};
            *(f32x2*)(DSEG + ((h * 2 + 1) * NSEG + seg) * 128 + 2 * lane) = (f32x2){__builtin_amdgcn_exp2f(pba), __builtin_amdgcn_exp2f(pbb)};
        }
    }
}

__device__ __forceinline__ void scan_combine(unsigned char* ws, int tid) {
    unsigned* SEGP = (unsigned*)(ws + WS_SEG); const float* DSEG = (const float*)(ws + WS_DSEG);
    const int gt = blockIdx.x * 512 + tid, NGT = gridDim.x * 512;
    for (int e = gt; e < 16 * 8192; e += NGT) {
        const int hd = e >> 13, vk = e & 8191, kp = vk & 63, dir = hd & 1;
        unsigned* base = SEGP + (size_t)hd * NSEG * 8192 + vk; const float* db = DSEG + hd * NSEG * 128 + 2 * kp;
        unsigned tv[NSEG]; f32x2 dv[NSEG];
#pragma unroll
        for (int st = 0; st < NSEG; ++st) { tv[st] = base[(size_t)st * 8192]; dv[st] = *(const f32x2*)(db + st * 128); }
        float s0 = 0.f, s1 = 0.f;
        if (dir == 0) {
#pragma unroll
            for (int st = 0; st < NSEG; ++st) { base[(size_t)st * 8192] = pk2(s0, s1); s0 = dv[st][0] * s0 + __uint_as_float(tv[st] << 16); s1 = dv[st][1] * s1 + __uint_as_float(tv[st] & 0xffff0000u); }
        } else {
#pragma unroll
            for (int st = NSEG - 1; st >= 0; --st) { base[(size_t)st * 8192] = pk2(s0, s1); s0 = dv[st][0] * s0 + __uint_as_float(tv[st] << 16); s1 = dv[st][1] * s1 + __uint_as_float(tv[st] & 0xffff0000u); }
        }
    }
}

__device__ __forceinline__ void sgu_item(LAS unsigned char* lds, unsigned char* ws, const float* lng, const float* lnb, const float* sgb, int item, int tid, int wid, int lane) {
    const int cidx = item >> 1, half = item & 1, tok0 = cidx * 128;
    const int r = lane & 31, hh = lane >> 5;
    const bf16* GV = (const bf16*)(ws + WS_GV); const bf16* U = (const bf16*)(ws + WS_U); bf16* BO = (bf16*)(ws + WS_BO); const bf16* SGW = (const bf16*)(ws + WS_SGW);
    constexpr int L_WS = 0, L_VN = 34816, L_MU = 52224, L_RSD = 52736, L_SG = 53248, LDSG = 68;
    LAS float* MU = (LAS float*)(lds + L_MU); LAS float* RSD = (LAS float*)(lds + L_RSD); LAS float* STG = (LAS float*)(lds + L_SG);
    const int e = tid & 63, sp = tid >> 6;
    u32x4 wsreg[4]; unsigned short gvs[16];
    {
        const int g = half * 4;
#pragma unroll
        for (int i = 0; i < 4; ++i) { const int idx = tid + 512 * i; wsreg[i] = *(const u32x4*)(SGW + (size_t)g * 16384 + (idx >> 4) * 128 + (idx & 15) * 8); }
#pragma unroll
        for (int i = 0; i < 16; ++i) gvs[i] = GV[(size_t)(tok0 + sp * 16 + i) * SGWD + g * 64 + e];
    }
    {
        u32x4 graw[16];
#pragma unroll
        for (int i = 0; i < 16; ++i) graw[i] = *(const u32x4*)(GV + (size_t)(tok0 + wid * 16 + i) * SGWD + lane * 8);
#pragma unroll
        for (int i = 0; i < 16; ++i) {
            const int s = wid * 16 + i; f32x4 a, b; { const u32x4 w = graw[i];
                a[0] = __uint_as_float(w.x << 16); a[1] = __uint_as_float(w.x & 0xffff0000u); a[2] = __uint_as_float(w.y << 16); a[3] = __uint_as_float(w.y & 0xffff0000u);
                b[0] = __uint_as_float(w.z << 16); b[1] = __uint_as_float(w.z & 0xffff0000u); b[2] = __uint_as_float(w.w << 16); b[3] = __uint_as_float(w.w & 0xffff0000u); }
            const float mean = wave_sum((a[0] + a[1]) + (a[2] + a[3]) + (b[0] + b[1]) + (b[2] + b[3])) * (1.f / SGWD);
            a = a - mean; b = b - mean;
            const float var = wave_sum((a[0] * a[0] + a[1] * a[1]) + (a[2] * a[2] + a[3] * a[3]) + (b[0] * b[0] + b[1] * b[1]) + (b[2] * b[2] + b[3] * b[3])) * (1.f / SGWD);
            if (lane == 0) { MU[s] = mean; RSD[s] = rsqrtf(var + EPS); }
        }
    }
    LBAR();
    for (int gi = 0; gi < 4; ++gi) {
        const int g = half * 4 + gi;
#pragma unroll
        for (int i = 0; i < 4; ++i) { const int idx = tid + 512 * i; *(LAS u32x4*)(lds + L_WS + ((idx >> 4) * LDQ + (idx & 15) * 8) * 2) = wsreg[i]; }
        {
            const float gg = lng[g * 64 + e], bb = lnb[g * 64 + e];
            unsigned pkd[8];
#pragma unroll
            for (int i = 0; i < 8; ++i) { const int s = sp * 16 + 2 * i;
                pkd[i] = pk2((bf2f(gvs[2 * i]) - MU[s]) * RSD[s] * gg + bb, (bf2f(gvs[2 * i + 1]) - MU[s + 1]) * RSD[s + 1] * gg + bb); }
            LAS u32x4* vp = (LAS u32x4*)(lds + L_VN + (e * LDQ + sp * 16) * 2);
            vp[0] = (u32x4){pkd[0], pkd[1], pkd[2], pkd[3]}; vp[1] = (u32x4){pkd[4], pkd[5], pkd[6], pkd[7]};
        }
        const int et = tid >> 3, eg8 = 8 * (tid & 7);
        u32x4 ureg[2];
#pragma unroll
        for (int j = 0; j < 2; ++j) ureg[j] = *(const u32x4*)(U + (size_t)(tok0 + et + 64 * j) * SGWD + g * 64 + eg8);
        if (gi + 1 < 4) {
#pragma unroll
            for (int i = 0; i < 4; ++i) { const int idx = tid + 512 * i; wsreg[i] = *(const u32x4*)(SGW + (size_t)(g + 1) * 16384 + (idx >> 4) * 128 + (idx & 15) * 8); }
#pragma unroll
            for (int i = 0; i < 16; ++i) gvs[i] = GV[(size_t)(tok0 + sp * 16 + i) * SGWD + (g + 1) * 64 + e];
        }
        LBAR();
        const int tb = wid >> 1, eb = wid & 1;
        f32x16 acc;
#pragma unroll
        for (int i = 0; i < 16; ++i) acc[i] = 0.f;
#pragma unroll
        for (int kk = 0; kk < 8; ++kk) {
            const bf16x8 a = *(const LAS bf16x8*)(lds + L_WS + ((tb * 32 + r) * LDQ + kk * 16 + 8 * hh) * 2);
            const bf16x8 b = *(const LAS bf16x8*)(lds + L_VN + ((eb * 32 + r) * LDQ + kk * 16 + 8 * hh) * 2);
            acc = MFMA32(a, b, acc);
        }
#pragma unroll
        for (int i = 0; i < 16; ++i) STG[(tb * 32 + rowf(i, hh)) * LDSG + eb * 32 + r] = acc[i];
        LBAR();
#pragma unroll
        for (int j = 0; j < 2; ++j) {
            const int t = et + 64 * j; const float bs = sgb[g * 128 + t];
            f32x4 a = *(const LAS f32x4*)(STG + t * LDSG + eg8), b = *(const LAS f32x4*)(STG + t * LDSG + eg8 + 4);
            f32x4 ua, ub; { const u32x4 w = ureg[j];
                ua[0] = __uint_as_float(w.x << 16); ua[1] = __uint_as_float(w.x & 0xffff0000u); ua[2] = __uint_as_float(w.y << 16); ua[3] = __uint_as_float(w.y & 0xffff0000u);
                ub[0] = __uint_as_float(w.z << 16); ub[1] = __uint_as_float(w.z & 0xffff0000u); ub[2] = __uint_as_float(w.w << 16); ub[3] = __uint_as_float(w.w & 0xffff0000u); }
            st8bf(BO + (size_t)(tok0 + t) * SGWD + g * 64 + eg8, (a + bs) * ua, (b + bs) * ub);
        }
        LBAR();
    }
}

#define RLX_AGENT __ATOMIC_RELAXED, __HIP_MEMORY_SCOPE_AGENT
#define XB_TMO      128
#define XB_XCNT(j)  (256  + 64 * (j))
#define XB_XSUB(j)  (1280 + 64 * (j))
#define XB_XGEN(j)  (2304 + 64 * (j))
#define XB_TOP      3328
#define XB_TOPGEN   3392
#define XCD_BAR_WORDS 3456
#define XB_SPIN_CAP (1u << 18)

__device__ __forceinline__ unsigned xb_ld(unsigned* p)              { return __hip_atomic_load(p, __ATOMIC_RELAXED, __HIP_MEMORY_SCOPE_AGENT); }
__device__ __forceinline__ unsigned xb_add(unsigned* p, unsigned v) { return __hip_atomic_fetch_add(p, v, __ATOMIC_RELAXED, __HIP_MEMORY_SCOPE_AGENT); }
__device__ __forceinline__ unsigned xb_xcc_id() { return (unsigned)__builtin_amdgcn_s_getreg((3 << 11) | 20) & 0xFu; }
#define XB_SPIN(cond, bar) do { unsigned _sp = 0; while (cond) { __builtin_amdgcn_s_sleep(1); \
    if ((++_sp & 255u) == 0u) { if (xb_ld(&(bar)[XB_TMO])) break; if (_sp > XB_SPIN_CAP) { atomicAdd(&(bar)[XB_TMO], 1u); break; } } } } while (0)

struct XcdBarrier {
    unsigned* bar; unsigned x;
    volatile LAS unsigned* st;
};

__device__ __forceinline__ XcdBarrier xcd_barrier_post(unsigned* bar, volatile LAS unsigned* st) {
    XcdBarrier b; b.bar = bar; b.x = xb_xcc_id(); b.st = st;
    if (threadIdx.x == 0) (void)xb_add(&bar[XB_XCNT(b.x)], 1u);
    return b;
}
__device__ __forceinline__ void xcd_barrier_complete(unsigned* bar, unsigned x, unsigned& nloc, unsigned& nx) {
    const unsigned G = gridDim.x * gridDim.y * gridDim.z;
    unsigned sum, cnt, mine, sp = 0u;
    for (;;) {
        sum = 0u; cnt = 0u; mine = 0u;
#pragma unroll
        for (unsigned j = 0; j < 16; ++j) { const unsigned c = xb_ld(&bar[XB_XCNT(j)]); sum += c; cnt += (c > 0u) ? 1u : 0u; mine = (j == x) ? c : mine; }
        if (sum == G) break;
        __builtin_amdgcn_s_sleep(1);
        if ((++sp & 255u) == 0u) { if (xb_ld(&bar[XB_TMO])) break; if (sp > XB_SPIN_CAP) { atomicAdd(&bar[XB_TMO], 1u); break; } }
    }
    nloc = mine > 0u ? mine : 1u; nx = cnt > 0u ? cnt : 1u;
}

__device__ __forceinline__ void xcd_barrier(const XcdBarrier& b) {
    asm volatile("s_waitcnt vmcnt(0)" ::: "memory");
    __syncthreads();
    if (threadIdx.x == 0) {
        unsigned* bar = b.bar;
        __builtin_amdgcn_s_waitcnt(0);
        unsigned nloc = b.st[0], nx = b.st[1];
        if (nloc == 0u) { xcd_barrier_complete(bar, b.x, nloc, nx); b.st[0] = nloc; b.st[1] = nx; }
        const unsigned old = xb_add(&bar[XB_XSUB(b.x)], 1u);
        const unsigned gen = old / nloc;
        if (old + 1u == (gen + 1u) * nloc) {
            __builtin_amdgcn_fence(__ATOMIC_RELEASE, "agent");
            asm volatile("s_waitcnt vmcnt(0)" ::: "memory");
            const unsigned og = xb_add(&bar[XB_TOP], 1u);
            const unsigned tg = og / nx;
            if (og + 1u == (tg + 1u) * nx) xb_add(&bar[XB_TOPGEN], 1u);
            else XB_SPIN(xb_ld(&bar[XB_TOPGEN]) == tg, bar);
            __builtin_amdgcn_fence(__ATOMIC_ACQUIRE, "agent");
            xb_add(&bar[XB_XGEN(b.x)], 1u);
            asm volatile("s_waitcnt vmcnt(0)" ::: "memory");
        } else {
            XB_SPIN(xb_ld(&bar[XB_XGEN(b.x)]) == gen, bar);
            __builtin_amdgcn_fence(__ATOMIC_ACQUIRE, "agent");
            asm volatile("s_waitcnt vmcnt(0)" ::: "memory");
        }
    }
    __syncthreads();
}

constexpr size_t WS_BAR = 512 * 1024;
constexpr size_t WS_CNT = 528 * 1024;
constexpr size_t WS_XB = 1280 * 1024;
constexpr size_t CTL_ZERO_BYTES = (528 + 192 - 512) * 1024;
constexpr int LDS_ST = LDS_BYTES - 16;
typedef const __attribute__((address_space(4))) Args* KArgs;
struct RowStat {
    float* xbuf; unsigned* cnt;
    __device__ __forceinline__ void run(const pg8::f32x4 (&v)[2][2][4][2], const pg8::Unit& u, int wr, int wc, int fr, int fq, LAS unsigned char* lds, int wid, int lane) const {
        LAS float* P = (LAS float*)lds;
        LAS float* S = (LAS float*)(lds + 8192);
#pragma unroll
        for (int ai = 0; ai < 2; ++ai)
#pragma unroll
            for (int m = 0; m < 4; ++m) {
                float q = 0.f;
#pragma unroll
                for (int bj = 0; bj < 2; ++bj)
#pragma unroll
                    for (int n = 0; n < 2; ++n) { const pg8::f32x4 x = v[ai][bj][m][n]; q += (x[0] * x[0] + x[1] * x[1]) + (x[2] * x[2] + x[3] * x[3]); }
                q += __shfl_xor(q, 16); q += __shfl_xor(q, 32);
                if (fq == 0) P[(ai * 128 + wr * 64 + m * 16 + fr) * 4 + wc] = q;
            }
        asm volatile("s_waitcnt lgkmcnt(0)" ::: "memory"); __builtin_amdgcn_s_barrier(); asm volatile("" ::: "memory");
        const int row = wid * 32 + (lane & 31);
        if (lane < 32) {
            const float t = (P[row * 4 + 0] + P[row * 4 + 1]) + (P[row * 4 + 2] + P[row * 4 + 3]);
            __hip_atomic_store(xbuf + ((size_t)(u.pm * 256 + row) * 4 + u.pn), t, __ATOMIC_RELAXED, __HIP_MEMORY_SCOPE_AGENT);
        }
        asm volatile("s_waitcnt vmcnt(0)" ::: "memory");
        if (lane == 0) __hip_atomic_fetch_add(cnt + 64 * u.pm, 1u, __ATOMIC_RELAXED, __HIP_MEMORY_SCOPE_AGENT);
        if (wid == 0) {
            unsigned sp = 0;
            while ((unsigned)__builtin_amdgcn_readfirstlane(__hip_atomic_load(cnt + 64 * u.pm, __ATOMIC_RELAXED, __HIP_MEMORY_SCOPE_AGENT)) < 32u) { if (++sp > (1u << 20)) break; __builtin_amdgcn_s_sleep(2); }
            __builtin_amdgcn_fence(__ATOMIC_ACQUIRE, "agent");
        }
        asm volatile("s_waitcnt vmcnt(0) lgkmcnt(0)" ::: "memory"); __builtin_amdgcn_s_barrier(); asm volatile("" ::: "memory");
        if (lane < 32) {
            const float* slot = xbuf + (size_t)(u.pm * 256 + row) * 4; float tot = 0.f;
#pragma unroll
            for (int t = 0; t < 4; ++t) tot += __hip_atomic_load(slot + t, __ATOMIC_RELAXED, __HIP_MEMORY_SCOPE_AGENT);
            S[row] = rsqrtf(tot * (1.f / D) + EPS);
        }
        asm volatile("s_waitcnt lgkmcnt(0)" ::: "memory"); __builtin_amdgcn_s_barrier(); asm volatile("" ::: "memory");
    }
};
struct EpiG4Fused {
    static constexpr bool PERM = true, AFTER_DRAIN = true; static constexpr int MID = 0;
    int l, b;
    __device__ __forceinline__ void fused(pg8::f32x4 (&acc)[2][2][4][2], const pg8::Unit& u, int wr, int wc, int fr, int fq, LAS unsigned char* lds, int wid, int lane) const {
        KArgs ka = (KArgs)__builtin_amdgcn_kernarg_segment_ptr(); asm volatile("" : "+s"(ka));
        unsigned char* ws = ka->ws;
        const float* xin = l == 0 ? ka->in[0] : ka->out; float* xout = ka->out;
        const float* g1 = ka->in[14] + l * D; const float* g2 = ka->in[15] + l * D;
        bf16* H2o = (bf16*)(ws + WS_MIX);
        const int inst = (l * 2 + b) * 2;
        const RowStat st1{(float*)(ws + WS_XB), (unsigned*)(ws + WS_CNT) + (size_t)inst * 4096};
        const RowStat st2{(float*)(ws + WS_XB) + 65536, (unsigned*)(ws + WS_CNT) + (size_t)(inst + 1) * 4096};
        const LAS float* S = (const LAS float*)(lds + 8192);
        const int col0 = u.pn * 256 + wc * 32 + 8 * fq;
        f32x4 pre[4][2][2];
#pragma unroll
        for (int m = 0; m < 4; ++m) { const size_t off = (size_t)(b * TB + u.pm * 256 + wr * 64 + m * 16 + fr) * D + col0;
#pragma unroll
            for (int bj = 0; bj < 2; ++bj)
#pragma unroll
                for (int n = 0; n < 2; ++n) pre[m][bj][n] = *(const f32x4*)(xin + off + bj * 128 + n * 4); }
        st1.run(acc, u, wr, wc, fr, fq, lds, wid, lane);
#pragma unroll
        for (int ai = 0; ai < 2; ++ai)
#pragma unroll
            for (int m = 0; m < 4; ++m) { const int r = ai * 128 + wr * 64 + m * 16 + fr; const float s1 = S[r]; const size_t off = (size_t)(b * TB + u.pm * 256 + r) * D + col0;
#pragma unroll
                for (int bj = 0; bj < 2; ++bj)
#pragma unroll
                    for (int n = 0; n < 2; ++n) { const f32x4 bs = pre[m][bj][n]; const f32x4 gg = *(const f32x4*)(g1 + col0 + bj * 128 + n * 4);
                        acc[ai][bj][m][n] = bs + acc[ai][bj][m][n] * s1 * gg; }
                asm volatile("" : "+v"(acc[ai][0][m][0]), "+v"(acc[ai][0][m][1]), "+v"(acc[ai][1][m][0]), "+v"(acc[ai][1][m][1]));
                if (ai == 0 && m == 3) {
                    asm volatile("" ::: "memory");
#pragma unroll
                    for (int m2 = 0; m2 < 4; ++m2) { const size_t off2 = (size_t)(b * TB + u.pm * 256 + 128 + wr * 64 + m2 * 16 + fr) * D + col0;
#pragma unroll
                        for (int bj = 0; bj < 2; ++bj)
#pragma unroll
                            for (int n = 0; n < 2; ++n) pre[m2][bj][n] = *(const f32x4*)(xin + off2 + bj * 128 + n * 4); }
                } }
        st2.run(acc, u, wr, wc, fr, fq, lds, wid, lane);
#pragma unroll
        for (int ai = 0; ai < 2; ++ai)
#pragma unroll
            for (int m = 0; m < 4; ++m) { const int r = ai * 128 + wr * 64 + m * 16 + fr; const float s2 = S[r]; const size_t off = (size_t)(b * TB + u.pm * 256 + r) * D + col0;
#pragma unroll
                for (int bj = 0; bj < 2; ++bj) { const f32x4 x0 = acc[ai][bj][m][0], x1 = acc[ai][bj][m][1];
                    *(f32x4*)(xout + off + bj * 128) = x0; *(f32x4*)(xout + off + bj * 128 + 4) = x1;
                    const f32x4 h0 = *(const f32x4*)(g2 + col0 + bj * 128), h1 = *(const f32x4*)(g2 + col0 + bj * 128 + 4);
                    st8bf(H2o + off + bj * 128, x0 * s2 * h0, x1 * s2 * h1); }
                asm volatile("" ::: "memory"); }
    }
};
struct EpiG6Fused {
    static constexpr bool PERM = true, AFTER_DRAIN = true; static constexpr int MID = 0;
    int l, b;
    __device__ __forceinline__ void fused(pg8::f32x4 (&acc)[2][2][4][2], const pg8::Unit& u, int wr, int wc, int fr, int fq, LAS unsigned char* lds, int wid, int lane) const {
        KArgs ka = (KArgs)__builtin_amdgcn_kernarg_segment_ptr(); asm volatile("" : "+s"(ka));
        unsigned char* ws = ka->ws;
        float* X = ka->out; const float* g3 = ka->in[19] + l * D;
        bf16* H2o = (bf16*)(ws + WS_H2);
        const RowStat st{(float*)(ws + WS_XB), (unsigned*)(ws + WS_CNT) + (size_t)(8 + l * 2 + b) * 4096};
        const LAS float* S = (const LAS float*)(lds + 8192);
        const int col0 = u.pn * 256 + wc * 32 + 8 * fq;
        f32x4 pre[4][2][2];
#pragma unroll
        for (int m = 0; m < 4; ++m) { const size_t off = (size_t)(b * TB + u.pm * 256 + wr * 64 + m * 16 + fr) * D + col0;
#pragma unroll
            for (int bj = 0; bj < 2; ++bj)
#pragma unroll
                for (int n = 0; n < 2; ++n) pre[m][bj][n] = *(const f32x4*)(X + off + bj * 128 + n * 4); }
        st.run(acc, u, wr, wc, fr, fq, lds, wid, lane);
#pragma unroll
        for (int ai = 0; ai < 2; ++ai)
#pragma unroll
            for (int m = 0; m < 4; ++m) { const int r = ai * 128 + wr * 64 + m * 16 + fr; const float s3 = S[r]; const size_t off = (size_t)(b * TB + u.pm * 256 + r) * D + col0;
#pragma unroll
                for (int bj = 0; bj < 2; ++bj) {
                    const f32x4 b0 = pre[m][bj][0], b1 = pre[m][bj][1];
                    const f32x4 h0 = *(const f32x4*)(g3 + col0 + bj * 128), h1 = *(const f32x4*)(g3 + col0 + bj * 128 + 4);
                    const f32x4 x0 = b0 + acc[ai][bj][m][0] * s3 * h0, x1 = b1 + acc[ai][bj][m][1] * s3 * h1;
                    *(f32x4*)(X + off + bj * 128) = x0; *(f32x4*)(X + off + bj * 128 + 4) = x1;
                    st8bf(H2o + off + bj * 128, x0, x1); }
                if (ai == 0 && m == 3) {
                    asm volatile("" ::: "memory");
#pragma unroll
                    for (int m2 = 0; m2 < 4; ++m2) { const size_t off2 = (size_t)(b * TB + u.pm * 256 + 128 + wr * 64 + m2 * 16 + fr) * D + col0;
#pragma unroll
                        for (int bj = 0; bj < 2; ++bj)
#pragma unroll
                            for (int n = 0; n < 2; ++n) pre[m2][bj][n] = *(const f32x4*)(X + off2 + bj * 128 + n * 4); }
                } }
    }
};
constexpr int PH_PER_LAYER = 18, N_PHASES = 2 * PH_PER_LAYER;
#ifndef PROBE_MASK
#define PROBE_MASK 0
#endif
__global__ void __launch_bounds__(512, 2) mega(Args a) {
    extern __shared__ __attribute__((aligned(16))) unsigned char lds_raw[];
    LAS unsigned char* lds = (LAS unsigned char*)lds_raw;
    if (threadIdx.x < 4) ((LAS unsigned*)(lds + LDS_ST))[threadIdx.x] = 0u;
    __syncthreads();
    (void)xcd_barrier_post((unsigned*)(a.ws + WS_BAR), (volatile LAS unsigned*)(lds + LDS_ST));
    int rep = 0;
    for (int st = a.ph_lo; ; ) {
        int tid = threadIdx.x; asm volatile("" : "+v"(tid));
        KArgs ka = (KArgs)__builtin_amdgcn_kernarg_segment_ptr(); asm volatile("" : "+s"(ka));
        unsigned char* ws = ka->ws; float* X = ka->out;
        int bid = blockIdx.x; asm volatile("" : "+s"(bid));
        const int lane = tid & 63, wave = __builtin_amdgcn_readfirstlane(tid >> 6);
        const int l = st / PH_PER_LAYER, idx = st % PH_PER_LAYER;
        const float* xin = l == 0 ? ka->in[0] : X;
        const bool fusedR1 = (gridDim.x == 256);
        if (fusedR1 && idx == 13) { ++st; continue; }
        const int kind = idx == 0 ? 0 : (idx <= 12 ? 1 + (idx - 1) % 6 : idx - 6);
        if (idx == 0) {
            prologue(ka, ws, l, lds, tid, wave, lane);
            rows_r0(xin, ka->in[2] + l * D, (bf16*)(ws + WS_H), 0, TB, wave, lane);
            if (fusedR1) {
                const float* pr = ka->in[1] + (size_t)l * T * PLE; bf16* pb = (bf16*)(ws + WS_PB2);
                for (size_t i = (size_t)bid * 512 + tid; i < (size_t)T * PLE / 8; i += (size_t)gridDim.x * 512) { f32x4 a, b; ldrow8(pr + 8 * i, a, b); st8bf(pb + 8 * i, a, b); }
            }
        } else if (idx <= 12) {
            const int b = (idx - 1) / 6, sub = (idx - 1) % 6;
            if (sub == 0) {
                EpiG1 E{ws, l == 0 ? 1 : 0};
                run_gemm(lds, (const bf16*)(ws + WS_H), (const bf16*)(ws + W_IN), TB, NIN, D, E, tid, bid);
            } else if (sub == 1) {
                for (int it = bid; it < 8 * NSEG; it += gridDim.x) scan_p1_item(lds, ws, it, tid, wave, lane);
                for (int it = bid; it < 128 * 2; it += gridDim.x) sgu_item(lds, ws, ka->in[9] + l * SGWD, ka->in[10] + l * SGWD, ka->in[8] + l * 1024, it, tid, wave, lane);
                if (b == 0) rows_r0(xin, ka->in[2] + l * D, (bf16*)(ws + WS_H), TB, TB, wave, lane);
            } else if (sub == 2) {
                scan_combine(ws, tid);
            } else if (sub == 3) {
                for (int it = bid; it < 8 * NSEG; it += gridDim.x) scan_item<true>(lds, ws, ka->in[6] + l * D, it, tid, wave, lane);
            } else if (sub == 4) {
                { EpiRow8<FG2> E{FG2{ws}};
                  run_gemm(lds, (const bf16*)(ws + WS_AO), (const bf16*)(ws + W_A), TB, D, D, E, tid, bid); }
                { int tid2 = threadIdx.x; asm volatile("" : "+v"(tid2)); KArgs ka2 = (KArgs)__builtin_amdgcn_kernarg_segment_ptr(); asm volatile("" : "+s"(ka2)); unsigned char* ws2 = ka2->ws; int bid2 = blockIdx.x; asm volatile("" : "+s"(bid2));
                  EpiRow8<FG3> E{FG3{ws2}};
                  run_gemm(lds, (const bf16*)(ws2 + WS_BO), (const bf16*)(ws2 + W_B), TB, D, SGWD, E, tid2, bid2); }
            } else if (fusedR1) {
                EpiG4Fused E{l, b};
                run_gemm<EpiG4Fused, false>(lds, (const bf16*)(ws + WS_Q), (const bf16*)(ws + W_O), TB, D, D, E, tid, bid);
            } else {
                EpiRow8<FStore> E{FStore{ws, WS_MIX + (size_t)b * TB * D * 2}};
                run_gemm(lds, (const bf16*)(ws + WS_Q), (const bf16*)(ws + W_O), TB, D, D, E, tid, bid);
            }
        } else if (idx == 13) {
            rows_r12(xin, X, (const bf16*)(ws + WS_MIX), ka->in[14] + l * D, ka->in[15] + l * D, (bf16*)(ws + WS_H2), nullptr, nullptr, wave, lane);
        } else if (idx == 14) {
            EpiSwiglu E{ws};
            run_gemm(lds, (const bf16*)(ws + (fusedR1 ? WS_MIX : WS_H2)), (const bf16*)(ws + W_GU), T, 2 * FF, D, E, tid, bid);
        } else if (fusedR1 && (idx == 15 || idx == 16)) {
            const int b = idx - 15;
            EpiG6Fused E{l, b};
            run_gemm<EpiG6Fused, false>(lds, (const bf16*)(ws + WS_HID) + (size_t)b * TB * FF, (const bf16*)(ws + W_DN), TB, D, FF, E, tid, bid);
        } else if (idx == 15) {
            EpiRow8<FStore> E{FStore{ws, WS_MIX}};
            run_gemm(lds, (const bf16*)(ws + WS_HID), (const bf16*)(ws + W_DN), T, D, FF, E, tid, bid);
        } else if (idx == 16) {
            rows_r12(X, X, (const bf16*)(ws + WS_MIX), ka->in[19] + l * D, nullptr, (bf16*)(ws + WS_H2), ka->in[1] + (size_t)l * T * PLE, (bf16*)(ws + WS_PB), wave, lane);
        } else {
            { EpiRow8<FSig> E{FSig{ws}};
              run_gemm(lds, (const bf16*)(ws + WS_H2), (const bf16*)(ws + W_PG), T, D, D, E, tid, bid); }
            { int tid2 = threadIdx.x; asm volatile("" : "+v"(tid2)); KArgs ka2 = (KArgs)__builtin_amdgcn_kernarg_segment_ptr(); asm volatile("" : "+s"(ka2)); unsigned char* ws2 = ka2->ws; int bid2 = blockIdx.x; asm volatile("" : "+s"(bid2));
              EpiRow8<FG8> E{FG8{ws2, ka2->out}};
              run_gemm(lds, (const bf16*)(ws2 + (gridDim.x == 256 ? WS_PB2 : WS_PB)), (const bf16*)(ws2 + W_PL), T, D, PLE, E, tid2, bid2); }
        }
        if (PROBE_MASK != 0 && rep == 0 && ((PROBE_MASK >> kind) & 1)) { rep = 1; __syncthreads(); continue; }
        rep = 0;
        if (st + 1 >= ka->ph_hi) break;
        if (ka->ph_lo < 0) cg::this_grid().sync();
        else { XcdBarrier xb; xb.bar = (unsigned*)(ka->ws + WS_BAR); xb.x = xb_xcc_id(); xb.st = (volatile LAS unsigned*)(lds + LDS_ST); xcd_barrier(xb); }
        ++st;
    }
}

extern "C" void kernel_launch(void* const* d_in, const int* in_sizes, int n_in, void* d_out, int out_size, void* d_ws, size_t ws_size, hipStream_t stream) {
    static int grid = 0;
    if (grid == 0) {
        if (n_in != 22 || ws_size < WS_END) { fprintf(stderr, "kernel_launch: unexpected n_in %d / ws_size %zu (need %zu)\n", n_in, ws_size, (size_t)WS_END); grid = -1; return; }
        int dev = 0, cus = 0, per_cu = 0;
        hipGetDevice(&dev); hipDeviceGetAttribute(&cus, hipDeviceAttributeMultiprocessorCount, dev);
        hipFuncSetAttribute((const void*)mega, hipFuncAttributeMaxDynamicSharedMemorySize, LDS_BYTES);
        hipOccupancyMaxActiveBlocksPerMultiprocessor(&per_cu, (const void*)mega, 512, LDS_BYTES);
        if (per_cu < 1) per_cu = 1;
        (void)hipGetLastError();
        grid = cus * per_cu;
    }
    if (grid < 0) return;
    if (hipMemsetAsync((char*)d_ws + WS_BAR, 0, CTL_ZERO_BYTES, stream) != hipSuccess) { fprintf(stderr, "memset failed\n"); return; }
    Args a{};
    for (int i = 0; i < 22; ++i) a.in[i] = (const float*)d_in[i];
    a.out = (float*)d_out; a.ws = (unsigned char*)d_ws; a.ph_lo = 0; a.ph_hi = N_PHASES;
    void* args[] = {&a};
    hipError_t e = hipLaunchCooperativeKernel((const void*)mega, dim3(grid), dim3(512), args, LDS_BYTES, stream);
    if (e != hipSuccess) fprintf(stderr, "cooperative launch failed: %s (grid %d)\n", hipGetErrorString(e), grid);
}
```

```cpp
#include <hip/hip_runtime.h>
#include <cstdio>
#include <cstdint>
namespace pg8 {
#define PG8_LAS __attribute__((address_space(3)))
typedef unsigned short bf16_t;
typedef short bf16x8 __attribute__((ext_vector_type(8)));
typedef float f32x4 __attribute__((ext_vector_type(4)));
typedef unsigned u32x4 __attribute__((ext_vector_type(4)));
constexpr int BM = 256, BK = 64, HALF = 128, HTB = HALF * BK * 2  , STAGE_BYTES = 8 * HTB, NXCD = 8, WGM = 4;

__host__ __device__ __forceinline__ int lds_byte(int r, int c) { const int st = (r >> 4) * 2 + (c >> 5), rr = r & 15, cc = c & 31, ob = rr * 64 + cc * 2; return st * 1024 + (ob ^ (((ob >> 9) & 1) << 5)); }
__host__ __device__ __forceinline__ void stage_rc(int b, int& R, int& C) { const int st = b / 1024, sb = b % 1024, swz = sb ^ (((sb >> 9) & 1) << 5); R = (st >> 1) * 16 + swz / 64; C = (st & 1) * 32 + (swz % 64) / 2; }
__host__ __device__ __forceinline__ int perm32(int rho) { const int n = rho >> 4, i = rho & 15; return 8 * (i >> 2) + 4 * n + (i & 3); }

struct Unit { int pm, pn; };
struct Gemm { const bf16_t* A; const bf16_t* Bt; int M, N, K; };

struct StaticOrder {
    int nM, nN, nwg, G, c;
    __host__ __device__ void init(int M, int N, int G_, int c_) { nM = M / BM; nN = N / BM; nwg = nM * nN; G = G_; c = c_; }
    __host__ __device__ bool next(int i, Unit& u) const {
        const long L = (long)i * G + c; if (L >= nwg) return false;
        int wgid = (int)L; { const int q = nwg / NXCD, r = nwg % NXCD, xcd = wgid % NXCD, off = wgid / NXCD; wgid = (xcd < r ? xcd * (q + 1) : r * (q + 1) + (xcd - r) * q) + off; }
        const int nig = WGM * nN, gid = wgid / nig, fm = gid * WGM, gsz = (nM - fm) < WGM ? (nM - fm) : WGM;
        u.pm = fm + ((wgid % nig) % gsz); u.pn = (wgid % nig) / gsz; return true;
    }
    __device__ __forceinline__ void a_ready(const Unit&) const {}
    __device__ __forceinline__ void done(const Unit&) const {}
};

__device__ __forceinline__ unsigned cvt_pk_bf16(float lo, float hi) { unsigned r; asm volatile("v_cvt_pk_bf16_f32 %0, %1, %2" : "=v"(r) : "v"(lo), "v"(hi)); return r; }
template <class Epi, class Sched, bool ALIGN_EPI = false, bool SP2 = false>
__device__ __forceinline__ void gemm_phase(PG8_LAS unsigned char* lds, const Gemm g, const Sched& S, const Epi& E, const int tid) {
    const int wid = __builtin_amdgcn_readfirstlane(tid >> 6), lane = tid & 63, wr = wid >> 2, wc = wid & 3, fr = lane & 15, fq = lane >> 4;
    const int K = g.K, nt = K / BK;
    unsigned voffA[2], voffB[2];
#pragma unroll
    for (int i = 0; i < 2; ++i) { int R, C; stage_rc(tid * 16 + i * 8192, R, C); const int Rb = Epi::PERM ? ((R & ~31) + perm32(R & 31)) : R;
        voffA[i] = (unsigned)(R * K + C) * 2u; voffB[i] = (unsigned)(Rb * K + C) * 2u; }
    const size_t kstep = (size_t)(BK * 2);
    const size_t hstep = (size_t)HALF * K * 2;
    const size_t tstep = 2 * hstep;
    const unsigned ldsw = (unsigned)wid * 1024u;
    const int aoff = lds_byte(wr * 64 + fr, fq * 8), boff = lds_byte(wc * 32 + fr, fq * 8);
#define PG8_SA(b, h) (((b) * 2 + (h)) * HTB)
#define PG8_SB(b, h) ((4 + (b) * 2 + (h)) * HTB)
#define PG8_STAGE(bufoff, gbase, voff) do { _Pragma("unroll") for (int _i = 0; _i < 2; ++_i) \
        __builtin_amdgcn_global_load_lds((const unsigned*)((const char*)(gbase) + (voff)[_i]), (PG8_LAS unsigned*)(lds + (bufoff) + ldsw + _i * 8192), 16, 0, 0); } while (0)
#define PG8_LDA(dst, b, h) do { _Pragma("unroll") for (int m = 0; m < 4; ++m) _Pragma("unroll") for (int k = 0; k < 2; ++k) dst[m][k] = *(const PG8_LAS bf16x8*)(lds + PG8_SA(b, h) + aoff + m * 2048 + k * 1024); } while (0)
#define PG8_LDB(dst, b, h) do { _Pragma("unroll") for (int n = 0; n < 2; ++n) _Pragma("unroll") for (int k = 0; k < 2; ++k) dst[n][k] = *(const PG8_LAS bf16x8*)(lds + PG8_SB(b, h) + boff + n * 2048 + k * 1024); } while (0)
#define PG8_MMA(ai, bj, At, Bt) do { __builtin_amdgcn_s_setprio(1); _Pragma("unroll") for (int m = 0; m < 4; ++m) _Pragma("unroll") for (int n = 0; n < 2; ++n) _Pragma("unroll") for (int k = 0; k < 2; ++k) \
        acc[ai][bj][m][n] = __builtin_amdgcn_mfma_f32_16x16x32_bf16(Bt[n][k], At[m][k], acc[ai][bj][m][n], 0, 0, 0); __builtin_amdgcn_s_setprio(0); } while (0)
#define PG8_WAIT_V(n) asm volatile("s_waitcnt vmcnt(" #n ")" ::: "memory")
#define PG8_WAIT_L(n) asm volatile("s_waitcnt lgkmcnt(" #n ")" ::: "memory")
#define PG8_BAR __builtin_amdgcn_s_barrier()
#define PG8_SCHED __builtin_amdgcn_sched_barrier(0)
    Unit cur, nxt; int ui = 0;
    if (!S.next(0, cur)) return;
    f32x4 acc[2][2][4][2];
#pragma unroll
    for (int a = 0; a < 2; ++a)
#pragma unroll
        for (int b = 0; b < 2; ++b)
#pragma unroll
            for (int m = 0; m < 4; ++m)
#pragma unroll
                for (int n = 0; n < 2; ++n) acc[a][b][m][n] = (f32x4){0.f, 0.f, 0.f, 0.f};
    bf16x8 At[4][2], B0[2][2], B1[2][2];
    const char* cA = (const char*)g.A + (size_t)cur.pm * tstep; const char* cB = (const char*)g.Bt + (size_t)cur.pn * tstep;
    S.a_ready(cur);
    if constexpr (SP2) {
        PG8_STAGE(PG8_SB(0, 0), cB, voffB); PG8_STAGE(PG8_SB(0, 1), cB + hstep, voffB); PG8_STAGE(PG8_SA(0, 0), cA, voffA); PG8_STAGE(PG8_SA(0, 1), cA + hstep, voffA);
        if (wr == 1) PG8_BAR;
        PG8_WAIT_V(2); PG8_BAR;
        PG8_STAGE(PG8_SB(1, 0), cB + kstep, voffB); PG8_STAGE(PG8_SA(1, 0), cA + kstep, voffA); PG8_STAGE(PG8_SB(1, 1), cB + hstep + kstep, voffB);
        PG8_WAIT_V(6); PG8_BAR;
    } else {
        PG8_STAGE(PG8_SB(0, 0), cB, voffB); PG8_STAGE(PG8_SA(0, 0), cA, voffA); PG8_STAGE(PG8_SB(0, 1), cB + hstep, voffB); PG8_STAGE(PG8_SA(0, 1), cA + hstep, voffA);
        if (wr == 1) PG8_BAR;
        PG8_WAIT_V(4); PG8_BAR;
        PG8_STAGE(PG8_SB(1, 0), cB + kstep, voffB); PG8_STAGE(PG8_SA(1, 0), cA + kstep, voffA); PG8_STAGE(PG8_SB(1, 1), cB + hstep + kstep, voffB);
        PG8_WAIT_V(6); PG8_BAR;
    }
    for (;;) {
        const bool has_next = S.next(ui + 1, nxt);
        const char* nA = has_next ? (const char*)g.A + (size_t)nxt.pm * tstep : cA; const char* nB = has_next ? (const char*)g.Bt + (size_t)nxt.pn * tstep : cB;
        for (int t = 0; t < nt; t += 2) {
            const bool last = (t == nt - 2);
            const char* a1 = cA + (size_t)(t + 1) * kstep;
            const char* a2 = last ? nA : cA + (size_t)(t + 2) * kstep; const char* b2 = last ? nB : cB + (size_t)(t + 2) * kstep;
            const char* a3 = a2 + kstep; const char* b3 = b2 + kstep;
            if (last && has_next) S.a_ready(nxt);
            if constexpr (SP2) {
            PG8_LDB(B0, 0, 0); PG8_LDB(B1, 0, 1); PG8_SCHED; PG8_LDA(At, 0, 0); PG8_STAGE(PG8_SA(1, 1), a1 + hstep, voffA);
            PG8_WAIT_V(8); PG8_WAIT_L(0); PG8_BAR; PG8_MMA(0, 0, At, B0); PG8_MMA(0, 1, At, B1); PG8_BAR; PG8_SCHED;
            PG8_LDA(At, 0, 1); PG8_STAGE(PG8_SB(0, 0), b2, voffB); PG8_STAGE(PG8_SB(0, 1), b2 + hstep, voffB); PG8_STAGE(PG8_SA(0, 0), a2, voffA);
            PG8_WAIT_V(8); PG8_WAIT_L(0); PG8_BAR; PG8_MMA(1, 0, At, B0); PG8_MMA(1, 1, At, B1); PG8_BAR; PG8_SCHED;
            PG8_LDB(B0, 1, 0); PG8_LDB(B1, 1, 1); PG8_SCHED; PG8_LDA(At, 1, 0); PG8_STAGE(PG8_SA(0, 1), a2 + hstep, voffA);
            PG8_WAIT_V(8); PG8_WAIT_L(0); PG8_BAR; PG8_MMA(0, 0, At, B0); PG8_MMA(0, 1, At, B1); PG8_BAR; PG8_SCHED;
            PG8_LDA(At, 1, 1); PG8_STAGE(PG8_SB(1, 0), b3, voffB); PG8_STAGE(PG8_SB(1, 1), b3 + hstep, voffB); PG8_STAGE(PG8_SA(1, 0), a3, voffA);
            PG8_WAIT_V(8); PG8_WAIT_L(0); PG8_BAR; PG8_MMA(1, 0, At, B0); PG8_MMA(1, 1, At, B1); PG8_BAR; PG8_SCHED;
            } else {
            PG8_LDB(B0, 0, 0); PG8_SCHED; PG8_LDA(At, 0, 0); PG8_STAGE(PG8_SA(1, 1), a1 + hstep, voffA);
            PG8_WAIT_L(8); PG8_BAR; PG8_WAIT_L(0); PG8_MMA(0, 0, At, B0); PG8_BAR; PG8_SCHED;
            PG8_LDB(B1, 0, 1); PG8_STAGE(PG8_SB(0, 0), b2, voffB);
            PG8_BAR; PG8_WAIT_L(0); PG8_MMA(0, 1, At, B1); PG8_BAR;
            PG8_LDA(At, 0, 1); PG8_STAGE(PG8_SA(0, 0), a2, voffA);
            PG8_BAR; PG8_WAIT_L(0); PG8_MMA(1, 0, At, B0); PG8_BAR; PG8_SCHED;
            PG8_STAGE(PG8_SB(0, 1), b2 + hstep, voffB);
            PG8_WAIT_V(6); PG8_BAR; PG8_MMA(1, 1, At, B1); PG8_BAR;
            PG8_LDB(B0, 1, 0); PG8_SCHED; PG8_LDA(At, 1, 0); PG8_STAGE(PG8_SA(0, 1), a2 + hstep, voffA);
            PG8_WAIT_L(8); PG8_BAR; PG8_WAIT_L(0); PG8_MMA(0, 0, At, B0); PG8_BAR; PG8_SCHED;
            PG8_LDB(B1, 1, 1); PG8_STAGE(PG8_SB(1, 0), b3, voffB);
            PG8_BAR; PG8_WAIT_L(0); PG8_MMA(0, 1, At, B1); PG8_BAR;
            PG8_LDA(At, 1, 1); PG8_STAGE(PG8_SA(1, 0), a3, voffA);
            PG8_BAR; PG8_WAIT_L(0); PG8_MMA(1, 0, At, B0); PG8_BAR; PG8_SCHED;
            PG8_STAGE(PG8_SB(1, 1), b3 + hstep, voffB);
            PG8_WAIT_V(6); PG8_BAR; PG8_MMA(1, 1, At, B1); PG8_BAR;
            }
        }
        if constexpr (ALIGN_EPI) { if (wr == 0) PG8_BAR; }
        if constexpr (!Epi::AFTER_DRAIN) { E(acc, cur, wr, wc, fr, fq); S.done(cur); }
        if (!has_next) break;
#pragma unroll
        for (int a = 0; a < 2; ++a)
#pragma unroll
            for (int b = 0; b < 2; ++b)
#pragma unroll
                for (int m = 0; m < 4; ++m)
#pragma unroll
                    for (int n = 0; n < 2; ++n) acc[a][b][m][n] = (f32x4){0.f, 0.f, 0.f, 0.f};
        cur = nxt; cA = nA; cB = nB; ++ui;
        if constexpr (ALIGN_EPI) { if (wr == 1) PG8_BAR; }
    }
    PG8_WAIT_V(0);
    if constexpr (!ALIGN_EPI) { if (wr == 0) PG8_BAR; }
    PG8_BAR;
    if constexpr (Epi::AFTER_DRAIN) { E.fused(acc, cur, wr, wc, fr, fq, lds, wid, lane); S.done(cur); }
#undef PG8_SA
#undef PG8_SB
#undef PG8_STAGE
#undef PG8_LDA
#undef PG8_LDB
#undef PG8_MMA
#undef PG8_WAIT_V
#undef PG8_WAIT_L
#undef PG8_BAR
#undef PG8_SCHED
}
}

#include <hip/hip_cooperative_groups.h>
namespace cg = cooperative_groups;
#define LAS __attribute__((address_space(3)))
typedef unsigned short bf16;
typedef float f32x4 __attribute__((ext_vector_type(4)));
typedef float f32x16 __attribute__((ext_vector_type(16)));
typedef short bf16x8 __attribute__((ext_vector_type(8)));
typedef unsigned u32x4 __attribute__((ext_vector_type(4)));
typedef unsigned u32x2 __attribute__((ext_vector_type(2)));
typedef float f32x2 __attribute__((ext_vector_type(2)));
#define MFMA32(a, b, c) __builtin_amdgcn_mfma_f32_32x32x16_bf16((a), (b), (c), 0, 0, 0)

constexpr int T = 32768, TB = 16384, D = 1024, NIN = 8192, FF = 2816, PLE = 256, SGWD = 512;
constexpr int NSEG = 32, SEGCH = 8;
constexpr float EPS = 1e-6f;
constexpr size_t MiB = 1u << 20;
constexpr size_t WS_LBT = 0;
constexpr size_t WS_DSEG = 64 * 1024;
constexpr size_t WS_SGW = 1 * MiB;
constexpr size_t WS_W = 2 * MiB;
constexpr size_t W_IN = WS_W, W_A = WS_W + 16 * MiB, W_B = WS_W + 18 * MiB, W_O = WS_W + 19 * MiB, W_GU = WS_W + 21 * MiB,
                 W_DN = WS_W + 32 * MiB, W_PG = WS_W + 32 * MiB + 5632 * 1024, W_PL = W_PG + 2 * MiB;
constexpr size_t WS_H = 42 * MiB;
constexpr size_t WS_MIX = 74 * MiB;
constexpr size_t WS_R = 138 * MiB;
constexpr size_t WS_Q = WS_R, WS_LF = WS_R + 32 * MiB, WS_LB = WS_R + 64 * MiB, WS_V = WS_R + 96 * MiB, WS_ZG = WS_R + 128 * MiB,
                 WS_U = WS_R + 160 * MiB, WS_GV = WS_R + 176 * MiB, WS_SA = WS_R + 192 * MiB, WS_SB = WS_R + 224 * MiB,
                 WS_BO = WS_R + 256 * MiB, WS_AO = WS_R + 272 * MiB, WS_SEG = WS_R + 304 * MiB;
constexpr size_t WS_HID = WS_R, WS_H2 = WS_R + 176 * MiB, WS_PB = WS_R + 240 * MiB;
constexpr size_t WS_PB2 = WS_R + 336 * MiB;
constexpr size_t WS_END = WS_R + 352 * MiB;
static_assert(W_PL + 1024 * 256 * 2 <= WS_H, "weights map");

constexpr int LDS_BYTES = 143360;

__device__ __forceinline__ float bf2f(unsigned b) { return __uint_as_float(b << 16); }
__device__ __forceinline__ unsigned f2bf(float f) { unsigned u = __float_as_uint(f); return (u + 0x7fffu + ((u >> 16) & 1u)) >> 16; }
typedef __bf16 bf16x2_t __attribute__((ext_vector_type(2)));
__device__ __forceinline__ unsigned pk2(float lo, float hi) { f32x2 v = {lo, hi}; bf16x2_t b = __builtin_convertvector(v, bf16x2_t); return __builtin_bit_cast(unsigned, b); }
__device__ __forceinline__ float sigm(float x) { return __builtin_amdgcn_rcpf(1.f + __builtin_amdgcn_exp2f(-1.44269504089f * x)); }
__device__ __forceinline__ float siluf(float x) { return x * sigm(x); }
__device__ __forceinline__ float geluf(float v) {
    const float av = fabsf(v), d = av * 0.2316418882f + 1.0f; const float t = __builtin_amdgcn_rcpf(d);
    float q = t * 0.5307027145f + (-0.7265760135f); q = q * t + 0.7107068705f; q = q * t + (-0.142248368f); q = q * t + 0.127414796f; q = q * t;
    const float e = __builtin_amdgcn_exp2f((v * v) * (-0.72134752044f));
    const float m = v * (q * e); return v < 0.f ? m : v - m; }
__device__ __forceinline__ unsigned f2h(float x) { _Float16 h = (_Float16)x; return (unsigned)__builtin_bit_cast(unsigned short, h); }
__device__ __forceinline__ float h2f(unsigned short b) { return (float)__builtin_bit_cast(_Float16, b); }
__device__ __forceinline__ void st8bf(bf16* p, f32x4 lo, f32x4 hi) {
    u32x4 w; w.x = pk2(lo[0], lo[1]); w.y = pk2(lo[2], lo[3]); w.z = pk2(hi[0], hi[1]); w.w = pk2(hi[2], hi[3]); *(u32x4*)p = w; }
__device__ __forceinline__ void ld8bf(const bf16* p, f32x4& lo, f32x4& hi) {
    const u32x4 w = *(const u32x4*)p;
    lo[0] = __uint_as_float(w.x << 16); lo[1] = __uint_as_float(w.x & 0xffff0000u); lo[2] = __uint_as_float(w.y << 16); lo[3] = __uint_as_float(w.y & 0xffff0000u);
    hi[0] = __uint_as_float(w.z << 16); hi[1] = __uint_as_float(w.z & 0xffff0000u); hi[2] = __uint_as_float(w.w << 16); hi[3] = __uint_as_float(w.w & 0xffff0000u); }
template <int CTRL> __device__ __forceinline__ float dppf(float v) { return __int_as_float(__builtin_amdgcn_update_dpp(0, __float_as_int(v), CTRL, 0xf, 0xf, true)); }
__device__ __forceinline__ float row16_sum(float v) {
    v += dppf<0xB1>(v);
    v += dppf<0x4E>(v);
    v += dppf<0x141>(v);
    v += dppf<0x140>(v);
    return v;
}
__device__ __forceinline__ float wave_sum(float v) {
    v = row16_sum(v);
    v += __shfl_xor(v, 16); v += __shfl_xor(v, 32);
    return v;
}

template <class F> struct EpiRow8 {
    static constexpr bool PERM = true, AFTER_DRAIN = false;
    F f;
    __device__ __forceinline__ void operator()(const pg8::f32x4 (&acc)[2][2][4][2], const pg8::Unit& u, int wr, int wc, int fr, int fq) const {
        { int t_ = threadIdx.x; asm volatile("" : "+v"(t_)); const int w_ = __builtin_amdgcn_readfirstlane(t_ >> 6), l_ = t_ & 63; wr = w_ >> 2; wc = w_ & 3; fr = l_ & 15; fq = l_ >> 4; }
        unsigned char* w = f.ws; asm volatile("" : "+s"(w));
#pragma unroll
        for (int ai = 0; ai < 2; ++ai)
#pragma unroll
            for (int m = 0; m < 4; ++m) {
                const int row = u.pm * 256 + ai * 128 + wr * 64 + m * 16 + fr;
#pragma unroll
                for (int bj = 0; bj < 2; ++bj) {
                    const int col = u.pn * 256 + bj * 128 + wc * 32 + 8 * fq;
                    f(w, row, col, acc[ai][bj][m][0], acc[ai][bj][m][1]);
                }
            }
    }
};
struct EpiSwiglu {
    static constexpr bool PERM = true, AFTER_DRAIN = false;
    unsigned char* ws;
    __device__ __forceinline__ void operator()(const pg8::f32x4 (&acc)[2][2][4][2], const pg8::Unit& u, int wr, int wc, int fr, int fq) const {
        { int t_ = threadIdx.x; asm volatile("" : "+v"(t_)); const int w_ = __builtin_amdgcn_readfirstlane(t_ >> 6), l_ = t_ & 63; wr = w_ >> 2; wc = w_ & 3; fr = l_ & 15; fq = l_ >> 4; }
        unsigned char* w = ws; asm volatile("" : "+s"(w));
        bf16* HID = (bf16*)(w + WS_HID);
#pragma unroll
        for (int ai = 0; ai < 2; ++ai)
#pragma unroll
            for (int m = 0; m < 4; ++m) {
                const int row = u.pm * 256 + ai * 128 + wr * 64 + m * 16 + fr;
                const int hcol = u.pn * 128 + wc * 32 + 8 * fq;
                f32x4 lo, hi;
#pragma unroll
                for (int i = 0; i < 4; ++i) { lo[i] = siluf(acc[ai][0][m][0][i]) * acc[ai][1][m][0][i]; hi[i] = siluf(acc[ai][0][m][1][i]) * acc[ai][1][m][1][i]; }
                st8bf(HID + (size_t)row * FF + hcol, lo, hi);
            }
    }
};

struct EpiG1 {
    static constexpr bool PERM = true, AFTER_DRAIN = false;
    unsigned char* ws; int lb0;
    template <int KIND> __device__ __forceinline__ void seg(unsigned char* w, size_t dst, int ld, int cbase, const float* lb, const pg8::f32x4 (&acc)[2][2][4][2], const pg8::Unit& u, int wr, int wc, int fr, int fq) const {
#pragma unroll
        for (int ai = 0; ai < 2; ++ai)
#pragma unroll
            for (int m = 0; m < 4; ++m) {
                const int row = u.pm * 256 + ai * 128 + wr * 64 + m * 16 + fr;
#pragma unroll
                for (int bj = 0; bj < 2; ++bj) {
                    const int c = u.pn * 256 + bj * 128 + wc * 32 + 8 * fq - cbase;
                    f32x4 lo = acc[ai][bj][m][0], hi = acc[ai][bj][m][1];
                    if (KIND == 4) {
                        const f32x4 l0 = *(const f32x4*)(lb + c), l1 = *(const f32x4*)(lb + c + 4);
                        float r[8];
                        if (lb0) {
#pragma unroll
                            for (int i = 0; i < 4; ++i) {
                                r[i] = fmaxf(-__log2f(1.f + __builtin_amdgcn_exp2f(-1.44269504089f * lo[i])), -126.f);
                                r[4 + i] = fmaxf(-__log2f(1.f + __builtin_amdgcn_exp2f(-1.44269504089f * hi[i])), -126.f);
                            }
                        } else {
#pragma unroll
                        for (int i = 0; i < 4; ++i) {
                            const float f0 = l0[i] + (1.f - l0[i]) * sigm(lo[i]); r[i] = __log2f(fmaxf(f0, 1.17549435e-38f));
                            const float f1 = l1[i] + (1.f - l1[i]) * sigm(hi[i]); r[4 + i] = __log2f(fmaxf(f1, 1.17549435e-38f));
                        }
                        }
                        u32x4 v; v.x = f2h(r[0]) | (f2h(r[1]) << 16); v.y = f2h(r[2]) | (f2h(r[3]) << 16); v.z = f2h(r[4]) | (f2h(r[5]) << 16); v.w = f2h(r[6]) | (f2h(r[7]) << 16);
                        *(u32x4*)((unsigned short*)(w + dst) + (size_t)row * ld + c) = v;
                    } else {
#pragma unroll
                        for (int i = 0; i < 4; ++i) {
                            if (KIND == 1) { lo[i] = siluf(lo[i]); hi[i] = siluf(hi[i]); }
                            if (KIND == 2) { lo[i] = geluf(lo[i]); hi[i] = geluf(hi[i]); }
                            if (KIND == 3) { lo[i] = sigm(lo[i]); hi[i] = sigm(hi[i]); }
                        }
                        st8bf((bf16*)(w + dst) + (size_t)row * ld + c, lo, hi);
                    }
                }
            }
    }
    __device__ __forceinline__ void operator()(const pg8::f32x4 (&acc)[2][2][4][2], const pg8::Unit& u, int wr, int wc, int fr, int fq) const {
        { int t_ = threadIdx.x; asm volatile("" : "+v"(t_)); const int w_ = __builtin_amdgcn_readfirstlane(t_ >> 6), l_ = t_ & 63; wr = w_ >> 2; wc = w_ & 3; fr = l_ & 15; fq = l_ >> 4; }
        unsigned char* w = ws; asm volatile("" : "+s"(w));
        const int sg = u.pn >> 1;
        const float* lbt = (const float*)(w + WS_LBT);
        if (sg < 2) seg<1>(w, WS_Q, D, 0, nullptr, acc, u, wr, wc, fr, fq);
        else if (sg < 4) seg<4>(w, WS_LF, D, 1024, lbt, acc, u, wr, wc, fr, fq);
        else if (sg < 6) seg<4>(w, WS_LB, D, 2048, lbt + 1024, acc, u, wr, wc, fr, fq);
        else if (sg < 8) seg<0>(w, WS_V, D, 3072, nullptr, acc, u, wr, wc, fr, fq);
        else if (sg < 10) seg<1>(w, WS_ZG, D, 4096, nullptr, acc, u, wr, wc, fr, fq);
        else if (sg == 10) seg<2>(w, WS_U, SGWD, 5120, nullptr, acc, u, wr, wc, fr, fq);
        else if (sg == 11) seg<2>(w, WS_GV, SGWD, 5632, nullptr, acc, u, wr, wc, fr, fq);
        else if (sg < 14) seg<3>(w, WS_SA, D, 6144, nullptr, acc, u, wr, wc, fr, fq);
        else seg<3>(w, WS_SB, D, 7168, nullptr, acc, u, wr, wc, fr, fq);
    }
};
struct FG2 { unsigned char* ws;
    __device__ __forceinline__ void operator()(unsigned char* w, int row, int col, f32x4 lo, f32x4 hi) const {
        f32x4 a, b; ld8bf((const bf16*)(w + WS_SA) + (size_t)row * D + col, a, b); st8bf((bf16*)(w + WS_Q) + (size_t)row * D + col, lo * a, hi * b); } };
struct FG3 { unsigned char* ws;
    __device__ __forceinline__ void operator()(unsigned char* w, int row, int col, f32x4 lo, f32x4 hi) const {
        f32x4 a, b, c, d; ld8bf((const bf16*)(w + WS_SB) + (size_t)row * D + col, a, b); bf16* m1 = (bf16*)(w + WS_Q) + (size_t)row * D + col; ld8bf(m1, c, d); st8bf(m1, c + lo * a, d + hi * b); } };
struct FStore { unsigned char* ws; size_t off;
    __device__ __forceinline__ void operator()(unsigned char* w, int row, int col, f32x4 lo, f32x4 hi) const { st8bf((bf16*)(w + off) + (size_t)row * D + col, lo, hi); } };
struct FSig { unsigned char* ws;
    __device__ __forceinline__ void operator()(unsigned char* w, int row, int col, f32x4 lo, f32x4 hi) const {
#pragma unroll
        for (int i = 0; i < 4; ++i) { lo[i] = sigm(lo[i]); hi[i] = sigm(hi[i]); }
        st8bf((bf16*)(w + WS_MIX) + (size_t)row * D + col, lo, hi); } };
struct FG8 { unsigned char* ws; float* X;
    __device__ __forceinline__ void operator()(unsigned char* w, int row, int col, f32x4 lo, f32x4 hi) const {
        f32x4 a, b; ld8bf((const bf16*)(w + WS_MIX) + (size_t)row * D + col, a, b);
        float* xp = X + (size_t)row * D + col; const f32x4 x0 = *(const f32x4*)xp, x1 = *(const f32x4*)(xp + 4);
        *(f32x4*)xp = x0 + lo * a; *(f32x4*)(xp + 4) = x1 + hi * b; } };

template <class Epi, bool ALIGN = true> __device__ __forceinline__ void run_gemm(LAS unsigned char* lds, const bf16* A, const bf16* Bt, int M, int N, int K, const Epi& E, int tid, int bid) {
    pg8::Gemm g{A, Bt, M, N, K}; pg8::StaticOrder S; S.init(M, N, (int)gridDim.x, bid);
    pg8::gemm_phase<Epi, pg8::StaticOrder, ALIGN, true>(lds, g, S, E, tid);
}

__device__ __forceinline__ void transpose_item(const float* W, int K, int N, bf16* WT, int mode, LAS float* scr, int item, int lane) {
    const int nblk = N / 32, kb = item / nblk, nb = item % nblk, k0 = 64 * kb, n0 = 32 * nb;
    const int r0 = mode == 0 ? n0 : (256 * (n0 >> 7) + (n0 & 127) + (mode == 2 ? 128 : 0));
#pragma unroll 8
    for (int i = 0; i < 32; ++i) { const int kk = 2 * i + (lane >> 5); scr[kk * 33 + (lane & 31)] = __builtin_nontemporal_load(W + (size_t)(k0 + kk) * N + n0 + (lane & 31)); }
    asm volatile("s_waitcnt lgkmcnt(0)" ::: "memory");
    const int c = lane & 7;
#pragma unroll
    for (int j = 0; j < 4; ++j) { const int n = (lane >> 3) + 8 * j; const LAS float* s = scr + (8 * c) * 33 + n;
        u32x4 o; o.x = pk2(s[0 * 33], s[1 * 33]); o.y = pk2(s[2 * 33], s[3 * 33]); o.z = pk2(s[4 * 33], s[5 * 33]); o.w = pk2(s[6 * 33], s[7 * 33]);
        *(u32x4*)(WT + (size_t)(r0 + n) * K + k0 + 8 * c) = o; }
    asm volatile("s_waitcnt lgkmcnt(0)" ::: "memory");
}

struct Args { const float* in[22]; float* out; unsigned char* ws; int ph_lo, ph_hi; };

__device__ __forceinline__ void prologue(const __attribute__((address_space(4))) Args* a, unsigned char* ws, int l, LAS unsigned char* lds, int tid, int wave, int lane) {
    LAS float* scr = (LAS float*)(lds + wave * 16384);
    const int gw = blockIdx.x * 8 + wave, NGW = gridDim.x * 8;
    constexpr int I_IN = 16 * 256, I_A = 16 * 32, I_B = 8 * 32, I_O = 16 * 32, I_G = 16 * 88, I_D = 44 * 32, I_PG = 16 * 32, I_PL = 4 * 32;
    constexpr int NIT = I_IN + I_A + I_B + I_O + 2 * I_G + I_D + I_PG + I_PL;
    for (int it = gw; it < NIT; it += NGW) {
        int r = it;
        if (r < I_IN) { transpose_item(a->in[3] + (size_t)l * D * NIN, D, NIN, (bf16*)(ws + W_IN), 0, scr, r, lane); continue; } r -= I_IN;
        if (r < I_A) { transpose_item(a->in[11] + (size_t)l * D * D, D, D, (bf16*)(ws + W_A), 0, scr, r, lane); continue; } r -= I_A;
        if (r < I_B) { transpose_item(a->in[12] + (size_t)l * SGWD * D, SGWD, D, (bf16*)(ws + W_B), 0, scr, r, lane); continue; } r -= I_B;
        if (r < I_O) { transpose_item(a->in[13] + (size_t)l * D * D, D, D, (bf16*)(ws + W_O), 0, scr, r, lane); continue; } r -= I_O;
        if (r < I_G) { transpose_item(a->in[16] + (size_t)l * D * FF, D, FF, (bf16*)(ws + W_GU), 1, scr, r, lane); continue; } r -= I_G;
        if (r < I_G) { transpose_item(a->in[17] + (size_t)l * D * FF, D, FF, (bf16*)(ws + W_GU), 2, scr, r, lane); continue; } r -= I_G;
        if (r < I_D) { transpose_item(a->in[18] + (size_t)l * FF * D, FF, D, (bf16*)(ws + W_DN), 0, scr, r, lane); continue; } r -= I_D;
        if (r < I_PG) { transpose_item(a->in[21] + (size_t)l * D * D, D, D, (bf16*)(ws + W_PG), 0, scr, r, lane); continue; } r -= I_PG;
        transpose_item(a->in[20] + (size_t)l * PLE * D, PLE, D, (bf16*)(ws + W_PL), 0, scr, r, lane);
    }
    const int gt = blockIdx.x * 512 + tid, NGT = gridDim.x * 512;
    for (int i = gt; i < 2048; i += NGT) {
        const float* gm = a->in[i < 1024 ? 4 : 5]; const int c = i & 1023;
        ((float*)(ws + WS_LBT))[i] = (l == 0) ? 0.f : 1.f / (1.f + __expf(gm[c] - gm[1024 + c]));
    }
    for (int i = gt; i < 8 * 128 * 128 / 2; i += NGT) {
        const float* s = a->in[7] + (size_t)l * 131072 + 2 * i;
        ((unsigned*)(ws + WS_SGW))[i] = pk2(s[0], s[1]);
    }
}

__device__ __forceinline__ void ldrow8(const float* p, f32x4& a, f32x4& b) { a = *(const f32x4*)p; b = *(const f32x4*)(p + 4); }
__device__ __forceinline__ float sq8(const f32x4& a, const f32x4& b) { return (a[0] * a[0] + a[1] * a[1]) + (a[2] * a[2] + a[3] * a[3]) + (b[0] * b[0] + b[1] * b[1]) + (b[2] * b[2] + b[3] * b[3]); }
__device__ __forceinline__ void rows_r0(const float* xin, const float* g, bf16* H, int row0, int nrows, int wave, int lane) {
    const int gw = blockIdx.x * 8 + wave, NGW = gridDim.x * 8;
    f32x4 ga[2], gb[2];
#pragma unroll
    for (int j = 0; j < 2; ++j) ldrow8(g + 8 * lane + 512 * j, ga[j], gb[j]);
    for (int m = gw; m < nrows; m += NGW) {
        const float* xr = xin + (size_t)(row0 + m) * D + 8 * lane; f32x4 va[2], vb[2]; float s = 0.f;
#pragma unroll
        for (int j = 0; j < 2; ++j) { ldrow8(xr + 512 * j, va[j], vb[j]); s += sq8(va[j], vb[j]); }
        const float r = rsqrtf(wave_sum(s) * (1.f / D) + EPS);
        bf16* o = H + (size_t)m * D + 8 * lane;
#pragma unroll
        for (int j = 0; j < 2; ++j) st8bf(o + 512 * j, va[j] * r * ga[j], vb[j] * r * gb[j]);
    }
}
__device__ __forceinline__ void rows_r12(const float* xin, float* xout, const bf16* Y, const float* g1, const float* g2, bf16* Hout, const float* prow, bf16* PB, int wave, int lane) {
    const int gw = blockIdx.x * 8 + wave, NGW = gridDim.x * 8;
    for (int m = gw; m < T; m += NGW) {
        const float* xr = xin + (size_t)m * D + 8 * lane; const bf16* yr = Y + (size_t)m * D + 8 * lane;
        f32x4 va[2], vb[2], ya[2], yb[2]; float s = 0.f;
#pragma unroll
        for (int j = 0; j < 2; ++j) { ldrow8(xr + 512 * j, va[j], vb[j]); ld8bf(yr + 512 * j, ya[j], yb[j]); s += sq8(ya[j], yb[j]); }
        f32x4 pv; if (prow) pv = *(const f32x4*)(prow + (size_t)m * PLE + 4 * lane);
        const float r = rsqrtf(wave_sum(s) * (1.f / D) + EPS);
        float s2 = 0.f;
#pragma unroll
        for (int j = 0; j < 2; ++j) { f32x4 ga, gb; ldrow8(g1 + 8 * lane + 512 * j, ga, gb); va[j] = va[j] + ya[j] * r * ga; vb[j] = vb[j] + yb[j] * r * gb;
            float* xo = xout + (size_t)m * D + 8 * lane + 512 * j; *(f32x4*)xo = va[j]; *(f32x4*)(xo + 4) = vb[j];
            s2 += sq8(va[j], vb[j]); }
        bf16* o = Hout + (size_t)m * D + 8 * lane;
        if (g2) {
            const float r2 = rsqrtf(wave_sum(s2) * (1.f / D) + EPS);
#pragma unroll
            for (int j = 0; j < 2; ++j) { f32x4 ga, gb; ldrow8(g2 + 8 * lane + 512 * j, ga, gb); st8bf(o + 512 * j, va[j] * r2 * ga, vb[j] * r2 * gb); }
        } else {
#pragma unroll
            for (int j = 0; j < 2; ++j) st8bf(o + 512 * j, va[j], vb[j]);
        }
        if (prow) { u32x2 w; w.x = pk2(pv[0], pv[1]); w.y = pk2(pv[2], pv[3]); *(u32x2*)(PB + (size_t)m * PLE + 4 * lane) = w; }
    }
}

constexpr int LDQ = 136, LDT = 72, LDSTG = 132;
constexpr int L_QD = 0, L_QS = 17408, L_KS = 34816, L_KDT = 52224, L_VT = 70656, L_ST = 89088, L_P = 123904, L_TOT = 133120, L_DV = 137216, L_RS = 137728;
static_assert(L_RS + 1024 <= LDS_BYTES - 16 && 64 * LDSTG * 4 <= L_KDT - L_QS, "lds map");
__device__ __forceinline__ int rowf(int reg, int hh) { return (reg & 3) + 8 * (reg >> 2) + 4 * hh; }

#define LBAR() asm volatile("s_waitcnt lgkmcnt(0)\n\ts_barrier" ::: "memory")
template <bool OUT>
__device__ __forceinline__ void scan_item(LAS unsigned char* lds, unsigned char* ws, const float* hgn_l, int item, int tid_in, int wid, int lane_in) {
    const int h = item / NSEG, seg = item % NSEG;
    float* SEG = (float*)(ws + WS_SEG); float* DSEG = (float*)(ws + WS_DSEG);
    const bf16* Qp = (const bf16*)(ws + WS_Q); const bf16* Vp = (const bf16*)(ws + WS_V); bf16* AOp = (bf16*)(ws + WS_AO); const bf16* ZGp = (const bf16*)(ws + WS_ZG);
    LAS unsigned short* QD = (LAS unsigned short*)(lds + L_QD); LAS unsigned short* QS = (LAS unsigned short*)(lds + L_QS); LAS unsigned short* KS = (LAS unsigned short*)(lds + L_KS);
    LAS float* TOT = (LAS float*)(lds + L_TOT); LAS float* DV = (LAS float*)(lds + L_DV); LAS float* RS = (LAS float*)(lds + L_RS);
    for (int dir = 0; dir < 2; ++dir) {
        if (OUT && dir == 1) __syncthreads();
        int tid = tid_in, lane = lane_in;
        asm volatile("" : "+v"(tid), "+v"(lane));
        f32x16 S[2];
        bf16* spb = (bf16*)SEG + (size_t)((h * 2 + dir) * NSEG + seg) * 16384;
        {
            const int r = lane & 31, hh = lane >> 5, kb = wid >> 1;
#pragma unroll
            for (int j = 0; j < 2; ++j) { const int vc = (2 * (wid & 1) + j) * 32 + r;
#pragma unroll
                for (int g = 0; g < 4; ++g) {
                    if (OUT) { const u32x2 w = *(const u32x2*)(spb + vc * 128 + kb * 32 + 8 * g + 4 * hh);
                        S[j][4 * g] = __uint_as_float(w.x << 16); S[j][4 * g + 1] = __uint_as_float(w.x & 0xffff0000u); S[j][4 * g + 2] = __uint_as_float(w.y << 16); S[j][4 * g + 3] = __uint_as_float(w.y & 0xffff0000u); }
                    else { S[j][4 * g] = 0.f; S[j][4 * g + 1] = 0.f; S[j][4 * g + 2] = 0.f; S[j][4 * g + 3] = 0.f; } } }
        }
        const unsigned short* LFp = (const unsigned short*)(ws + (dir ? WS_LB : WS_LF));
        unsigned lraw[8], vraw[8], qraw[8];
        float dsa = 0.f, dsb = 0.f;
        const int es = dir ? -D : D;
        {
            const int c = seg * SEGCH + (dir ? SEGCH - 1 : 0);
            const unsigned e0 = (unsigned)((c * 64 + (dir ? 63 - wid * 8 : wid * 8)) * D + h * 128 + 2 * lane);
#pragma unroll
            for (int i = 0; i < 8; ++i) lraw[i] = *(const unsigned*)(LFp + (e0 + (unsigned)(i * es)));
#pragma unroll
            for (int i = 0; i < 8; ++i) vraw[i] = *(const unsigned*)(Vp + (e0 + (unsigned)(i * es)));
            if (OUT) {
#pragma unroll
                for (int i = 0; i < 8; ++i) qraw[i] = *(const unsigned*)(Qp + (e0 + (unsigned)(i * es)));
            }
        }
        for (int ci = 0; ci < SEGCH; ++ci) {
            asm volatile("" : "+v"(tid), "+v"(lane));
            const int r = lane & 31, hh = lane >> 5;
            const int c = seg * SEGCH + (dir ? SEGCH - 1 - ci : ci), tok0 = c * 64;
            if (OUT) {
                const int kb = wid >> 1;
#pragma unroll
                for (int j = 0; j < 2; ++j) { const int vcol = (2 * (wid & 1) + j) * 32 + r;
#pragma unroll
                    for (int g = 0; g < 4; ++g) { u32x2 w; w.x = pk2(S[j][4 * g], S[j][4 * g + 1]); w.y = pk2(S[j][4 * g + 2], S[j][4 * g + 3]);
                        *(LAS u32x2*)(lds + L_ST + (vcol * LDQ + kb * 32 + 8 * g + 4 * hh) * 2) = w; } }
            }
            float bla[8], blb[8], lfa[8], lfb[8]; float runa = 0.f, runb = 0.f;
#pragma unroll
            for (int i = 0; i < 8; ++i) { lfa[i] = h2f((unsigned short)(lraw[i] & 0xffffu)); lfb[i] = h2f((unsigned short)(lraw[i] >> 16)); runa += lfa[i]; runb += lfb[i]; bla[i] = runa; blb[i] = runb; }
            *(LAS f32x2*)(TOT + wid * 128 + 2 * lane) = (f32x2){runa, runb};
            LBAR();
            float offa = 0.f, offb = 0.f, bma = 0.f, bmb = 0.f, bta = 0.f, btb = 0.f;
#pragma unroll
            for (int p = 0; p < 8; ++p) { const f32x2 t = *(const LAS f32x2*)(TOT + p * 128 + 2 * lane);
                if (p < wid) { offa += t[0]; offb += t[1]; } if (p < 4) { bma += t[0]; bmb += t[1]; } bta += t[0]; btb += t[1]; }
            const float c1a = __builtin_amdgcn_exp2f(bta - bma), c1b = __builtin_amdgcn_exp2f(btb - bmb), c2a = __builtin_amdgcn_exp2f(bma), c2b = __builtin_amdgcn_exp2f(bmb);
            float kda[8], kdb[8];
#pragma unroll
            for (int i = 0; i < 8; ++i) {
                const float ba = bla[i] + offa, bb = blb[i] + offb;
                const float kka = 1.f - __builtin_amdgcn_exp2f(lfa[i]), kkb = 1.f - __builtin_amdgcn_exp2f(lfb[i]);
                if (OUT) {
                    const int tau = wid * 8 + i;
                    const float qa = __uint_as_float(qraw[i] << 16), qb = __uint_as_float(qraw[i] & 0xffff0000u);
                    const float qsa = qa * __builtin_amdgcn_exp2f(fminf(ba - bma, 115.f)), qsb = qb * __builtin_amdgcn_exp2f(fminf(bb - bmb, 115.f));
                    const float ksa = kka * __builtin_amdgcn_exp2f(fminf(bma - ba, 115.f)), ksb = kkb * __builtin_amdgcn_exp2f(fminf(bmb - bb, 115.f));
                    kda[i] = ksa * c1a; kdb[i] = ksb * c1b;
                    *(LAS unsigned*)(lds + L_QD + (tau * LDQ + 2 * lane) * 2) = pk2(qsa * c2a, qsb * c2b);
                    *(LAS unsigned*)(lds + L_QS + (tau * LDQ + 2 * lane) * 2) = pk2(qsa, qsb);
                    *(LAS unsigned*)(lds + L_KS + (tau * LDQ + 2 * lane) * 2) = pk2(ksa, ksb);
                } else {
                    kda[i] = kka * __builtin_amdgcn_exp2f(bta - ba); kdb[i] = kkb * __builtin_amdgcn_exp2f(btb - bb);
                }
            }
            {
                LAS u32x4* kp = (LAS u32x4*)(lds + L_KDT + ((2 * lane) * LDT + wid * 8) * 2); LAS u32x4* vp = (LAS u32x4*)(lds + L_VT + ((2 * lane) * LDT + wid * 8) * 2);
                kp[0] = (u32x4){pk2(kda[0], kda[1]), pk2(kda[2], kda[3]), pk2(kda[4], kda[5]), pk2(kda[6], kda[7])};
                kp[LDT * 2 / 16] = (u32x4){pk2(kdb[0], kdb[1]), pk2(kdb[2], kdb[3]), pk2(kdb[4], kdb[5]), pk2(kdb[6], kdb[7])};
                u32x4 va, vb;
#pragma unroll
                for (int j = 0; j < 4; ++j) { va[j] = (vraw[2 * j] & 0xffffu) | (vraw[2 * j + 1] << 16); vb[j] = (vraw[2 * j] >> 16) | (vraw[2 * j + 1] & 0xffff0000u); }
                vp[0] = va; vp[LDT * 2 / 16] = vb;
            }
            if (wid == 0) { *(LAS f32x2*)(DV + 2 * lane) = (f32x2){__builtin_amdgcn_exp2f(bta), __builtin_amdgcn_exp2f(btb)}; dsa += bta; dsb += btb; }
            if (ci + 1 < SEGCH) {
                const int cn = seg * SEGCH + (dir ? SEGCH - 2 - ci : ci + 1);
                const unsigned e0 = (unsigned)((cn * 64 + (dir ? 63 - wid * 8 : wid * 8)) * D + h * 128 + 2 * lane);
#pragma unroll
                for (int i = 0; i < 8; ++i) lraw[i] = *(const unsigned*)(LFp + (e0 + (unsigned)(i * es)));
#pragma unroll
                for (int i = 0; i < 8; ++i) vraw[i] = *(const unsigned*)(Vp + (e0 + (unsigned)(i * es)));
                if (OUT) {
#pragma unroll
                    for (int i = 0; i < 8; ++i) qraw[i] = *(const unsigned*)(Qp + (e0 + (unsigned)(i * es)));
                }
            }
            u32x4 aoraw[2], zgraw[2];
            const int otb = wid >> 2, ovb = wid & 3, ovc = ovb * 32 + r;
            const int ftau = tid >> 4, fv0 = 8 * (tid & 15);
            if (OUT && dir == 1) {
#pragma unroll
                for (int j = 0; j < 2; ++j) { const unsigned ad = (unsigned)((tok0 + 63 - (ftau + 32 * j)) * D + h * 128 + fv0); aoraw[j] = *(const u32x4*)(AOp + ad); zgraw[j] = *(const u32x4*)(ZGp + ad); }
            }
            LBAR();
            if (OUT) {
                if (wid < 4) {
                    const int tb = wid >> 1, sb = wid & 1;
                    f32x16 p;
#pragma unroll
                    for (int i = 0; i < 16; ++i) p[i] = 0.f;
                    if (!(tb == 0 && sb == 1)) {
#pragma unroll
                        for (int kk = 0; kk < 8; ++kk) {
                            const bf16x8 a = *(const LAS bf16x8*)(lds + L_QS + ((tb * 32 + r) * LDQ + kk * 16 + 8 * hh) * 2);
                            const bf16x8 b = *(const LAS bf16x8*)(lds + L_KS + ((sb * 32 + r) * LDQ + kk * 16 + 8 * hh) * 2);
                            p = MFMA32(a, b, p);
                        }
                    }
                    LAS unsigned short* P = (LAS unsigned short*)(lds + L_P);
#pragma unroll
                    for (int i = 0; i < 16; ++i) { const int row = tb * 32 + rowf(i, hh), col = sb * 32 + r; P[row * LDT + col] = (unsigned short)f2bf(col <= row ? p[i] : 0.f); }
                }
                else {
                const int kb = wid >> 1;
#pragma unroll
                for (int j = 0; j < 2; ++j) {
                    const int vb = 2 * (wid & 1) + j;
#pragma unroll
                    for (int i = 0; i < 16; ++i) S[j][i] *= DV[kb * 32 + rowf(i, hh)];
#pragma unroll
                    for (int kk = 0; kk < 4; ++kk) {
                        const bf16x8 a = *(const LAS bf16x8*)(lds + L_KDT + ((kb * 32 + r) * LDT + kk * 16 + 8 * hh) * 2);
                        const bf16x8 b = *(const LAS bf16x8*)(lds + L_VT + ((vb * 32 + r) * LDT + kk * 16 + 8 * hh) * 2);
                        S[j] = MFMA32(a, b, S[j]);
                    }
                }
            }
                LBAR();
            }
            f32x16 o;
            if (OUT) {
#pragma unroll
                for (int i = 0; i < 16; ++i) o[i] = 0.f;
#pragma unroll
                for (int kk = 0; kk < 8; ++kk) {
                    const bf16x8 a = *(const LAS bf16x8*)(lds + L_QD + ((otb * 32 + r) * LDQ + kk * 16 + 8 * hh) * 2);
                    const bf16x8 b = *(const LAS bf16x8*)(lds + L_ST + ((ovb * 32 + r) * LDQ + kk * 16 + 8 * hh) * 2);
                    o = MFMA32(a, b, o);
                }
#pragma unroll
                for (int kk = 0; kk < 4; ++kk) {
                    const bf16x8 a = *(const LAS bf16x8*)(lds + L_P + ((otb * 32 + r) * LDT + kk * 16 + 8 * hh) * 2);
                    const bf16x8 b = *(const LAS bf16x8*)(lds + L_VT + ((ovb * 32 + r) * LDT + kk * 16 + 8 * hh) * 2);
                    o = MFMA32(a, b, o);
                }
            }
            if (!OUT || wid < 4) {
                const int kb = wid >> 1;
#pragma unroll
                for (int j = 0; j < 2; ++j) {
                    const int vb = 2 * (wid & 1) + j;
#pragma unroll
                    for (int i = 0; i < 16; ++i) S[j][i] *= DV[kb * 32 + rowf(i, hh)];
#pragma unroll
                    for (int kk = 0; kk < 4; ++kk) {
                        const bf16x8 a = *(const LAS bf16x8*)(lds + L_KDT + ((kb * 32 + r) * LDT + kk * 16 + 8 * hh) * 2);
                        const bf16x8 b = *(const LAS bf16x8*)(lds + L_VT + ((vb * 32 + r) * LDT + kk * 16 + 8 * hh) * 2);
                        S[j] = MFMA32(a, b, S[j]);
                    }
                }
            }
            if (OUT) {
                LAS float* STG = (LAS float*)(lds + L_QS);
#pragma unroll
                for (int i = 0; i < 16; ++i) STG[(otb * 32 + rowf(i, hh)) * LDSTG + ovc] = o[i];
                LBAR();
#pragma unroll
                for (int j = 0; j < 2; ++j) {
                    const int tau = ftau + 32 * j;
                    f32x4 a = *(const LAS f32x4*)(STG + tau * LDSTG + fv0), b = *(const LAS f32x4*)(STG + tau * LDSTG + fv0 + 4);
                    if (dir == 0) {
                        st8bf(AOp + (unsigned)((tok0 + tau) * D + h * 128 + fv0), a, b);
                    } else {
                        f32x4 fa, fb, za, zb;
                        { const u32x4 w = aoraw[j];
                          fa[0] = __uint_as_float(w.x << 16); fa[1] = __uint_as_float(w.x & 0xffff0000u); fa[2] = __uint_as_float(w.y << 16); fa[3] = __uint_as_float(w.y & 0xffff0000u);
                          fb[0] = __uint_as_float(w.z << 16); fb[1] = __uint_as_float(w.z & 0xffff0000u); fb[2] = __uint_as_float(w.w << 16); fb[3] = __uint_as_float(w.w & 0xffff0000u); }
                        { const u32x4 w = zgraw[j];
                          za[0] = __uint_as_float(w.x << 16); za[1] = __uint_as_float(w.x & 0xffff0000u); za[2] = __uint_as_float(w.y << 16); za[3] = __uint_as_float(w.y & 0xffff0000u);
                          zb[0] = __uint_as_float(w.z << 16); zb[1] = __uint_as_float(w.z & 0xffff0000u); zb[2] = __uint_as_float(w.w << 16); zb[3] = __uint_as_float(w.w & 0xffff0000u); }
                        a = a + fa; b = b + fb;
                        float ss = (a[0] * a[0] + a[1] * a[1]) + (a[2] * a[2] + a[3] * a[3]) + (b[0] * b[0] + b[1] * b[1]) + (b[2] * b[2] + b[3] * b[3]);
                        ss = row16_sum(ss);
                        const float rstd = rsqrtf(ss * (1.f / 128.f) + EPS);
                        const f32x4 g0 = *(const f32x4*)(hgn_l + h * 128 + fv0), g1 = *(const f32x4*)(hgn_l + h * 128 + fv0 + 4);
                        st8bf(AOp + (unsigned)((tok0 + 63 - tau) * D + h * 128 + fv0), a * rstd * g0 * za, b * rstd * g1 * zb);
                    }
                }
            }
            LBAR();
        }
        if (!OUT) {
            const int r = lane & 31, hh = lane >> 5, kb = wid >> 1;
#pragma unroll
            for (int j = 0; j < 2; ++j) { const int vc = (2 * (wid & 1) + j) * 32 + r;
#pragma unroll
                for (int g = 0; g < 4; ++g) { u32x2 w; w.x = pk2(S[j][4 * g], S[j][4 * g + 1]); w.y = pk2(S[j][4 * g + 2], S[j][4 * g + 3]);
                    *(u32x2*)(spb + vc * 128 + kb * 32 + 8 * g + 4 * hh) = w; } }
            if (wid == 0) *(f32x2*)(DSEG + ((h * 2 + dir) * NSEG + seg) * 128 + 2 * lane) = (f32x2){__builtin_amdgcn_exp2f(dsa), __builtin_amdgcn_exp2f(dsb)};
        }
    }
}

__device__ __forceinline__ void scan_p1_item(LAS unsigned char* lds, unsigned char* ws, int item, int tid_in, int wid, int lane_in) {
    const int h = item / NSEG, seg = item % NSEG;
    float* SEG = (float*)(ws + WS_SEG); float* DSEG = (float*)(ws + WS_DSEG);
    const unsigned short* LFp = (const unsigned short*)(ws + WS_LF); const unsigned short* LBp = (const unsigned short*)(ws + WS_LB); const bf16* Vp = (const bf16*)(ws + WS_V);
    constexpr int P_KF = 0, P_KB = 18432, P_VT = 36864, P_TOT = 55296, P_DV = 63488;
    LAS float* TOT = (LAS float*)(lds + P_TOT); LAS float* DV = (LAS float*)(lds + P_DV);
    int tid = tid_in, lane = lane_in;
    asm volatile("" : "+v"(tid), "+v"(lane));
    f32x16 Sf[2], Sb[2];
#pragma unroll
    for (int j = 0; j < 2; ++j)
#pragma unroll
        for (int i = 0; i < 16; ++i) { Sf[j][i] = 0.f; Sb[j][i] = 0.f; }
    float dsfa = 0.f, dsfb = 0.f, pba = 0.f, pbb = 0.f;
    unsigned lraw[8], braw[8], vraw[8];
    {
        const unsigned e0 = (unsigned)(((seg * SEGCH) * 64 + wid * 8) * D + h * 128 + 2 * lane);
#pragma unroll
        for (int i = 0; i < 8; ++i) lraw[i] = *(const unsigned*)(LFp + (e0 + (unsigned)(i * D)));
#pragma unroll
        for (int i = 0; i < 8; ++i) braw[i] = *(const unsigned*)(LBp + (e0 + (unsigned)(i * D)));
#pragma unroll
        for (int i = 0; i < 8; ++i) vraw[i] = *(const unsigned*)(Vp + (e0 + (unsigned)(i * D)));
    }
    for (int ci = 0; ci < SEGCH; ++ci) {
        asm volatile("" : "+v"(tid), "+v"(lane));
        const int r = lane & 31, hh = lane >> 5;
        float blfa[8], blfb[8], lfa[8], lfb[8], blba[8], blbb[8], lba[8], lbb[8]; float rfa = 0.f, rfb = 0.f, rba = 0.f, rbb = 0.f;
#pragma unroll
        for (int i = 0; i < 8; ++i) {
            lfa[i] = h2f((unsigned short)(lraw[i] & 0xffffu)); lfb[i] = h2f((unsigned short)(lraw[i] >> 16)); rfa += lfa[i]; rfb += lfb[i]; blfa[i] = rfa; blfb[i] = rfb;
            lba[i] = h2f((unsigned short)(braw[i] & 0xffffu)); lbb[i] = h2f((unsigned short)(braw[i] >> 16)); blba[i] = rba; blbb[i] = rbb; rba += lba[i]; rbb += lbb[i];
        }
        *(LAS f32x2*)(TOT + wid * 128 + 2 * lane) = (f32x2){rfa, rfb};
        *(LAS f32x2*)(TOT + (8 + wid) * 128 + 2 * lane) = (f32x2){rba, rbb};
        LBAR();
        float offa = 0.f, offb = 0.f, bta = 0.f, btb = 0.f, oba = 0.f, obb = 0.f, tba = 0.f, tbb = 0.f;
#pragma unroll
        for (int p = 0; p < 8; ++p) { const f32x2 t = *(const LAS f32x2*)(TOT + p * 128 + 2 * lane), u = *(const LAS f32x2*)(TOT + (8 + p) * 128 + 2 * lane);
            if (p < wid) { offa += t[0]; offb += t[1]; oba += u[0]; obb += u[1]; } bta += t[0]; btb += t[1]; tba += u[0]; tbb += u[1]; }
        float kfa[8], kfb[8], kba[8], kbb[8];
#pragma unroll
        for (int i = 0; i < 8; ++i) {
            kfa[i] = (1.f - __builtin_amdgcn_exp2f(lfa[i])) * __builtin_amdgcn_exp2f(bta - (blfa[i] + offa));
            kfb[i] = (1.f - __builtin_amdgcn_exp2f(lfb[i])) * __builtin_amdgcn_exp2f(btb - (blfb[i] + offb));
            kba[i] = (1.f - __builtin_amdgcn_exp2f(lba[i])) * __builtin_amdgcn_exp2f(pba + oba + blba[i]);
            kbb[i] = (1.f - __builtin_amdgcn_exp2f(lbb[i])) * __builtin_amdgcn_exp2f(pbb + obb + blbb[i]);
        }
        {
            LAS u32x4* kf = (LAS u32x4*)(lds + P_KF + ((2 * lane) * LDT + wid * 8) * 2); LAS u32x4* kb_ = (LAS u32x4*)(lds + P_KB + ((2 * lane) * LDT + wid * 8) * 2); LAS u32x4* vp = (LAS u32x4*)(lds + P_VT + ((2 * lane) * LDT + wid * 8) * 2);
            kf[0] = (u32x4){pk2(kfa[0], kfa[1]), pk2(kfa[2], kfa[3]), pk2(kfa[4], kfa[5]), pk2(kfa[6], kfa[7])};
            kf[LDT * 2 / 16] = (u32x4){pk2(kfb[0], kfb[1]), pk2(kfb[2], kfb[3]), pk2(kfb[4], kfb[5]), pk2(kfb[6], kfb[7])};
            kb_[0] = (u32x4){pk2(kba[0], kba[1]), pk2(kba[2], kba[3]), pk2(kba[4], kba[5]), pk2(kba[6], kba[7])};
            kb_[LDT * 2 / 16] = (u32x4){pk2(kbb[0], kbb[1]), pk2(kbb[2], kbb[3]), pk2(kbb[4], kbb[5]), pk2(kbb[6], kbb[7])};
            u32x4 va, vb;
#pragma unroll
            for (int j = 0; j < 4; ++j) { va[j] = (vraw[2 * j] & 0xffffu) | (vraw[2 * j + 1] << 16); vb[j] = (vraw[2 * j] >> 16) | (vraw[2 * j + 1] & 0xffff0000u); }
            vp[0] = va; vp[LDT * 2 / 16] = vb;
        }
        if (wid == 0) { *(LAS f32x2*)(DV + 2 * lane) = (f32x2){__builtin_amdgcn_exp2f(bta), __builtin_amdgcn_exp2f(btb)}; dsfa += bta; dsfb += btb; }
        pba += tba; pbb += tbb;
        if (ci + 1 < SEGCH) {
            const unsigned e0 = (unsigned)(((seg * SEGCH + ci + 1) * 64 + wid * 8) * D + h * 128 + 2 * lane);
#pragma unroll
            for (int i = 0; i < 8; ++i) lraw[i] = *(const unsigned*)(LFp + (e0 + (unsigned)(i * D)));
#pragma unroll
            for (int i = 0; i < 8; ++i) braw[i] = *(const unsigned*)(LBp + (e0 + (unsigned)(i * D)));
#pragma unroll
            for (int i = 0; i < 8; ++i) vraw[i] = *(const unsigned*)(Vp + (e0 + (unsigned)(i * D)));
        }
        LBAR();
        {
            const int kb = wid >> 1;
#pragma unroll
            for (int j = 0; j < 2; ++j) {
                const int vb = 2 * (wid & 1) + j;
#pragma unroll
                for (int i = 0; i < 16; ++i) Sf[j][i] *= DV[kb * 32 + rowf(i, hh)];
#pragma unroll
                for (int kk = 0; kk < 4; ++kk) {
                    const bf16x8 b = *(const LAS bf16x8*)(lds + P_VT + ((vb * 32 + r) * LDT + kk * 16 + 8 * hh) * 2);
                    const bf16x8 af = *(const LAS bf16x8*)(lds + P_KF + ((kb * 32 + r) * LDT + kk * 16 + 8 * hh) * 2);
                    const bf16x8 ab = *(const LAS bf16x8*)(lds + P_KB + ((kb * 32 + r) * LDT + kk * 16 + 8 * hh) * 2);
                    Sf[j] = MFMA32(af, b, Sf[j]); Sb[j] = MFMA32(ab, b, Sb[j]);
                }
            }
        }
    }
    LBAR();
    {
        const int r = lane & 31, hh = lane >> 5, kb = wid >> 1;
        bf16* spf = (bf16*)SEG + (size_t)((h * 2 + 0) * NSEG + seg) * 16384; bf16* spb = (bf16*)SEG + (size_t)((h * 2 + 1) * NSEG + seg) * 16384;
#pragma unroll
        for (int j = 0; j < 2; ++j) { const int vc = (2 * (wid & 1) + j) * 32 + r;
#pragma unroll
            for (int g = 0; g < 4; ++g) { const int o = vc * 128 + kb * 32 + 8 * g + 4 * hh; u32x2 wf, wb;
                wf.x = pk2(Sf[j][4 * g], Sf[j][4 * g + 1]); wf.y = pk2(Sf[j][4 * g + 2], Sf[j][4 * g + 3]); wb.x = pk2(Sb[j][4 * g], Sb[j][4 * g + 1]); wb.y = pk2(Sb[j][4 * g + 2], Sb[j][4 * g + 3]);
                *(u32x2*)(spf + o) = wf; *(u32x2*)(spb + o) = wb; } }
        if (wid == 0) {
            *(f32x2*)(DSEG + ((h * 2 + 0) * NSEG + seg) * 128 + 2 * lane) = (f32x2){__builtin_amdgcn_exp2f(dsfa), __builtin_amdgcn_exp2f(dsfb)};
            *(f32x2*)(DSEG + ((h * 2 + 1) * NSEG + seg) * 128 + 2 * lane) = (f32x2){__builtin_amdgcn_exp2f(pba), __builtin_amdgcn_exp2f(pbb)};
        }
    }
}

__device__ __forceinline__ void scan_combine(unsigned char* ws, int tid) {
    unsigned* SEGP = (unsigned*)(ws + WS_SEG); const float* DSEG = (const float*)(ws + WS_DSEG);
    const int gt = blockIdx.x * 512 + tid, NGT = gridDim.x * 512;
    for (int e = gt; e < 16 * 8192; e += NGT) {
        const int hd = e >> 13, vk = e & 8191, kp = vk & 63, dir = hd & 1;
        unsigned* base = SEGP + (size_t)hd * NSEG * 8192 + vk; const float* db = DSEG + hd * NSEG * 128 + 2 * kp;
        unsigned tv[NSEG]; f32x2 dv[NSEG];
#pragma unroll
        for (int st = 0; st < NSEG; ++st) { tv[st] = base[(size_t)st * 8192]; dv[st] = *(const f32x2*)(db + st * 128); }
        float s0 = 0.f, s1 = 0.f;
        if (dir == 0) {
#pragma unroll
            for (int st = 0; st < NSEG; ++st) { base[(size_t)st * 8192] = pk2(s0, s1); s0 = dv[st][0] * s0 + __uint_as_float(tv[st] << 16); s1 = dv[st][1] * s1 + __uint_as_float(tv[st] & 0xffff0000u); }
        } else {
#pragma unroll
            for (int st = NSEG - 1; st >= 0; --st) { base[(size_t)st * 8192] = pk2(s0, s1); s0 = dv[st][0] * s0 + __uint_as_float(tv[st] << 16); s1 = dv[st][1] * s1 + __uint_as_float(tv[st] & 0xffff0000u); }
        }
    }
}

__device__ __forceinline__ void sgu_item(LAS unsigned char* lds, unsigned char* ws, const float* lng, const float* lnb, const float* sgb, int item, int tid, int wid, int lane) {
    const int cidx = item >> 1, half = item & 1, tok0 = cidx * 128;
    const int r = lane & 31, hh = lane >> 5;
    const bf16* GV = (const bf16*)(ws + WS_GV); const bf16* U = (const bf16*)(ws + WS_U); bf16* BO = (bf16*)(ws + WS_BO); const bf16* SGW = (const bf16*)(ws + WS_SGW);
    constexpr int L_WS = 0, L_VN = 34816, L_MU = 52224, L_RSD = 52736, L_SG = 53248, LDSG = 68;
    LAS float* MU = (LAS float*)(lds + L_MU); LAS float* RSD = (LAS float*)(lds + L_RSD); LAS float* STG = (LAS float*)(lds + L_SG);
    const int e = tid & 63, sp = tid >> 6;
    u32x4 wsreg[4]; unsigned short gvs[16];
    {
        const int g = half * 4;
#pragma unroll
        for (int i = 0; i < 4; ++i) { const int idx = tid + 512 * i; wsreg[i] = *(const u32x4*)(SGW + (size_t)g * 16384 + (idx >> 4) * 128 + (idx & 15) * 8); }
#pragma unroll
        for (int i = 0; i < 16; ++i) gvs[i] = GV[(size_t)(tok0 + sp * 16 + i) * SGWD + g * 64 + e];
    }
    {
        u32x4 graw[16];
#pragma unroll
        for (int i = 0; i < 16; ++i) graw[i] = *(const u32x4*)(GV + (size_t)(tok0 + wid * 16 + i) * SGWD + lane * 8);
#pragma unroll
        for (int i = 0; i < 16; ++i) {
            const int s = wid * 16 + i; f32x4 a, b; { const u32x4 w = graw[i];
                a[0] = __uint_as_float(w.x << 16); a[1] = __uint_as_float(w.x & 0xffff0000u); a[2] = __uint_as_float(w.y << 16); a[3] = __uint_as_float(w.y & 0xffff0000u);
                b[0] = __uint_as_float(w.z << 16); b[1] = __uint_as_float(w.z & 0xffff0000u); b[2] = __uint_as_float(w.w << 16); b[3] = __uint_as_float(w.w & 0xffff0000u); }
            const float mean = wave_sum((a[0] + a[1]) + (a[2] + a[3]) + (b[0] + b[1]) + (b[2] + b[3])) * (1.f / SGWD);
            a = a - mean; b = b - mean;
            const float var = wave_sum((a[0] * a[0] + a[1] * a[1]) + (a[2] * a[2] + a[3] * a[3]) + (b[0] * b[0] + b[1] * b[1]) + (b[2] * b[2] + b[3] * b[3])) * (1.f / SGWD);
            if (lane == 0) { MU[s] = mean; RSD[s] = rsqrtf(var + EPS); }
        }
    }
    LBAR();
    for (int gi = 0; gi < 4; ++gi) {
        const int g = half * 4 + gi;
#pragma unroll
        for (int i = 0; i < 4; ++i) { const int idx = tid + 512 * i; *(LAS u32x4*)(lds + L_WS + ((idx >> 4) * LDQ + (idx & 15) * 8) * 2) = wsreg[i]; }
        {
            const float gg = lng[g * 64 + e], bb = lnb[g * 64 + e];
            unsigned pkd[8];
#pragma unroll
            for (int i = 0; i < 8; ++i) { const int s = sp * 16 + 2 * i;
                pkd[i] = pk2((bf2f(gvs[2 * i]) - MU[s]) * RSD[s] * gg + bb, (bf2f(gvs[2 * i + 1]) - MU[s + 1]) * RSD[s + 1] * gg + bb); }
            LAS u32x4* vp = (LAS u32x4*)(lds + L_VN + (e * LDQ + sp * 16) * 2);
            vp[0] = (u32x4){pkd[0], pkd[1], pkd[2], pkd[3]}; vp[1] = (u32x4){pkd[4], pkd[5], pkd[6], pkd[7]};
        }
        const int et = tid >> 3, eg8 = 8 * (tid & 7);
        u32x4 ureg[2];
#pragma unroll
        for (int j = 0; j < 2; ++j) ureg[j] = *(const u32x4*)(U + (size_t)(tok0 + et + 64 * j) * SGWD + g * 64 + eg8);
        if (gi + 1 < 4) {
#pragma unroll
            for (int i = 0; i < 4; ++i) { const int idx = tid + 512 * i; wsreg[i] = *(const u32x4*)(SGW + (size_t)(g + 1) * 16384 + (idx >> 4) * 128 + (idx & 15) * 8); }
#pragma unroll
            for (int i = 0; i < 16; ++i) gvs[i] = GV[(size_t)(tok0 + sp * 16 + i) * SGWD + (g + 1) * 64 + e];
        }
        LBAR();
        const int tb = wid >> 1, eb = wid & 1;
        f32x16 acc;
#pragma unroll
        for (int i = 0; i < 16; ++i) acc[i] = 0.f;
#pragma unroll
        for (int kk = 0; kk < 8; ++kk) {
            const bf16x8 a = *(const LAS bf16x8*)(lds + L_WS + ((tb * 32 + r) * LDQ + kk * 16 + 8 * hh) * 2);
            const bf16x8 b = *(const LAS bf16x8*)(lds + L_VN + ((eb * 32 + r) * LDQ + kk * 16 + 8 * hh) * 2);
            acc = MFMA32(a, b, acc);
        }
#pragma unroll
        for (int i = 0; i < 16; ++i) STG[(tb * 32 + rowf(i, hh)) * LDSG + eb * 32 + r] = acc[i];
        LBAR();
#pragma unroll
        for (int j = 0; j < 2; ++j) {
            const int t = et + 64 * j; const float bs = sgb[g * 128 + t];
            f32x4 a = *(const LAS f32x4*)(STG + t * LDSG + eg8), b = *(const LAS f32x4*)(STG + t * LDSG + eg8 + 4);
            f32x4 ua, ub; { const u32x4 w = ureg[j];
                ua[0] = __uint_as_float(w.x << 16); ua[1] = __uint_as_float(w.x & 0xffff0000u); ua[2] = __uint_as_float(w.y << 16); ua[3] = __uint_as_float(w.y & 0xffff0000u);
                ub[0] = __uint_as_float(w.z << 16); ub[1] = __uint_as_float(w.z & 0xffff0000u); ub[2] = __uint_as_float(w.w << 16); ub[3] = __uint_as_float(w.w & 0xffff0000u); }
            st8bf(BO + (size_t)(tok0 + t) * SGWD + g * 64 + eg8, (a + bs) * ua, (b + bs) * ub);
        }
        LBAR();
    }
}

#define RLX_AGENT __ATOMIC_RELAXED, __HIP_MEMORY_SCOPE_AGENT
#define XB_TMO      128
#define XB_XCNT(j)  (256  + 64 * (j))
#define XB_XSUB(j)  (1280 + 64 * (j))
#define XB_XGEN(j)  (2304 + 64 * (j))
#define XB_TOP      3328
#define XB_TOPGEN   3392
#define XCD_BAR_WORDS 3456
#define XB_SPIN_CAP (1u << 18)

__device__ __forceinline__ unsigned xb_ld(unsigned* p)              { return __hip_atomic_load(p, __ATOMIC_RELAXED, __HIP_MEMORY_SCOPE_AGENT); }
__device__ __forceinline__ unsigned xb_add(unsigned* p, unsigned v) { return __hip_atomic_fetch_add(p, v, __ATOMIC_RELAXED, __HIP_MEMORY_SCOPE_AGENT); }
__device__ __forceinline__ unsigned xb_xcc_id() { return (unsigned)__builtin_amdgcn_s_getreg((3 << 11) | 20) & 0xFu; }
#define XB_SPIN(cond, bar) do { unsigned _sp = 0; while (cond) { __builtin_amdgcn_s_sleep(1); \
    if ((++_sp & 255u) == 0u) { if (xb_ld(&(bar)[XB_TMO])) break; if (_sp > XB_SPIN_CAP) { atomicAdd(&(bar)[XB_TMO], 1u); break; } } } } while (0)

struct XcdBarrier {
    unsigned* bar; unsigned x;
    volatile LAS unsigned* st;
};

__device__ __forceinline__ XcdBarrier xcd_barrier_post(unsigned* bar, volatile LAS unsigned* st) {
    XcdBarrier b; b.bar = bar; b.x = xb_xcc_id(); b.st = st;
    if (threadIdx.x == 0) (void)xb_add(&bar[XB_XCNT(b.x)], 1u);
    return b;
}
__device__ __forceinline__ void xcd_barrier_complete(unsigned* bar, unsigned x, unsigned& nloc, unsigned& nx) {
    const unsigned G = gridDim.x * gridDim.y * gridDim.z;
    unsigned sum, cnt, mine, sp = 0u;
    for (;;) {
        sum = 0u; cnt = 0u; mine = 0u;
#pragma unroll
        for (unsigned j = 0; j < 16; ++j) { const unsigned c = xb_ld(&bar[XB_XCNT(j)]); sum += c; cnt += (c > 0u) ? 1u : 0u; mine = (j == x) ? c : mine; }
        if (sum == G) break;
        __builtin_amdgcn_s_sleep(1);
        if ((++sp & 255u) == 0u) { if (xb_ld(&bar[XB_TMO])) break; if (sp > XB_SPIN_CAP) { atomicAdd(&bar[XB_TMO], 1u); break; } }
    }
    nloc = mine > 0u ? mine : 1u; nx = cnt > 0u ? cnt : 1u;
}

__device__ __forceinline__ void xcd_barrier(const XcdBarrier& b) {
    asm volatile("s_waitcnt vmcnt(0)" ::: "memory");
    __syncthreads();
    if (threadIdx.x == 0) {
        unsigned* bar = b.bar;
        __builtin_amdgcn_s_waitcnt(0);
        unsigned nloc = b.st[0], nx = b.st[1];
        if (nloc == 0u) { xcd_barrier_complete(bar, b.x, nloc, nx); b.st[0] = nloc; b.st[1] = nx; }
        const unsigned old = xb_add(&bar[XB_XSUB(b.x)], 1u);
        const unsigned gen = old / nloc;
        if (old + 1u == (gen + 1u) * nloc) {
            __builtin_amdgcn_fence(__ATOMIC_RELEASE, "agent");
            asm volatile("s_waitcnt vmcnt(0)" ::: "memory");
            const unsigned og = xb_add(&bar[XB_TOP], 1u);
            const unsigned tg = og / nx;
            if (og + 1u == (tg + 1u) * nx) xb_add(&bar[XB_TOPGEN], 1u);
            else XB_SPIN(xb_ld(&bar[XB_TOPGEN]) == tg, bar);
            __builtin_amdgcn_fence(__ATOMIC_ACQUIRE, "agent");
            xb_add(&bar[XB_XGEN(b.x)], 1u);
            asm volatile("s_waitcnt vmcnt(0)" ::: "memory");
        } else {
            XB_SPIN(xb_ld(&bar[XB_XGEN(b.x)]) == gen, bar);
            __builtin_amdgcn_fence(__ATOMIC_ACQUIRE, "agent");
            asm volatile("s_waitcnt vmcnt(0)" ::: "memory");
        }
    }
    __syncthreads();
}

constexpr size_t WS_BAR = 512 * 1024;
constexpr size_t WS_CNT = 528 * 1024;
constexpr size_t WS_XB = 1280 * 1024;
constexpr size_t CTL_ZERO_BYTES = (528 + 192 - 512) * 1024;
constexpr int LDS_ST = LDS_BYTES - 16;
typedef const __attribute__((address_space(4))) Args* KArgs;
struct RowStat {
    float* xbuf; unsigned* cnt;
    __device__ __forceinline__ void run(const pg8::f32x4 (&v)[2][2][4][2], const pg8::Unit& u, int wr, int wc, int fr, int fq, LAS unsigned char* lds, int wid, int lane) const {
        LAS float* P = (LAS float*)lds;
        LAS float* S = (LAS float*)(lds + 8192);
#pragma unroll
        for (int ai = 0; ai < 2; ++ai)
#pragma unroll
            for (int m = 0; m < 4; ++m) {
                float q = 0.f;
#pragma unroll
                for (int bj = 0; bj < 2; ++bj)
#pragma unroll
                    for (int n = 0; n < 2; ++n) { const pg8::f32x4 x = v[ai][bj][m][n]; q += (x[0] * x[0] + x[1] * x[1]) + (x[2] * x[2] + x[3] * x[3]); }
                q += __shfl_xor(q, 16); q += __shfl_xor(q, 32);
                if (fq == 0) P[(ai * 128 + wr * 64 + m * 16 + fr) * 4 + wc] = q;
            }
        asm volatile("s_waitcnt lgkmcnt(0)" ::: "memory"); __builtin_amdgcn_s_barrier(); asm volatile("" ::: "memory");
        const int row = wid * 32 + (lane & 31);
        if (lane < 32) {
            const float t = (P[row * 4 + 0] + P[row * 4 + 1]) + (P[row * 4 + 2] + P[row * 4 + 3]);
            __hip_atomic_store(xbuf + ((size_t)(u.pm * 256 + row) * 4 + u.pn), t, __ATOMIC_RELAXED, __HIP_MEMORY_SCOPE_AGENT);
        }
        asm volatile("s_waitcnt vmcnt(0)" ::: "memory");
        if (lane == 0) __hip_atomic_fetch_add(cnt + 64 * u.pm, 1u, __ATOMIC_RELAXED, __HIP_MEMORY_SCOPE_AGENT);
        if (wid == 0) {
            unsigned sp = 0;
            while ((unsigned)__builtin_amdgcn_readfirstlane(__hip_atomic_load(cnt + 64 * u.pm, __ATOMIC_RELAXED, __HIP_MEMORY_SCOPE_AGENT)) < 32u) { if (++sp > (1u << 20)) break; __builtin_amdgcn_s_sleep(2); }
            __builtin_amdgcn_fence(__ATOMIC_ACQUIRE, "agent");
        }
        asm volatile("s_waitcnt vmcnt(0) lgkmcnt(0)" ::: "memory"); __builtin_amdgcn_s_barrier(); asm volatile("" ::: "memory");
        if (lane < 32) {
            const float* slot = xbuf + (size_t)(u.pm * 256 + row) * 4; float tot = 0.f;
#pragma unroll
            for (int t = 0; t < 4; ++t) tot += __hip_atomic_load(slot + t, __ATOMIC_RELAXED, __HIP_MEMORY_SCOPE_AGENT);
            S[row] = rsqrtf(tot * (1.f / D) + EPS);
        }
        asm volatile("s_waitcnt lgkmcnt(0)" ::: "memory"); __builtin_amdgcn_s_barrier(); asm volatile("" ::: "memory");
    }
};
struct EpiG4Fused {
    static constexpr bool PERM = true, AFTER_DRAIN = true; static constexpr int MID = 0;
    int l, b;
    __device__ __forceinline__ void fused(pg8::f32x4 (&acc)[2][2][4][2], const pg8::Unit& u, int wr, int wc, int fr, int fq, LAS unsigned char* lds, int wid, int lane) const {
        KArgs ka = (KArgs)__builtin_amdgcn_kernarg_segment_ptr(); asm volatile("" : "+s"(ka));
        unsigned char* ws = ka->ws;
        const float* xin = l == 0 ? ka->in[0] : ka->out; float* xout = ka->out;
        const float* g1 = ka->in[14] + l * D; const float* g2 = ka->in[15] + l * D;
        bf16* H2o = (bf16*)(ws + WS_MIX);
        const int inst = (l * 2 + b) * 2;
        const RowStat st1{(float*)(ws + WS_XB), (unsigned*)(ws + WS_CNT) + (size_t)inst * 4096};
        const RowStat st2{(float*)(ws + WS_XB) + 65536, (unsigned*)(ws + WS_CNT) + (size_t)(inst + 1) * 4096};
        const LAS float* S = (const LAS float*)(lds + 8192);
        const int col0 = u.pn * 256 + wc * 32 + 8 * fq;
        f32x4 pre[4][2][2];
#pragma unroll
        for (int m = 0; m < 4; ++m) { const size_t off = (size_t)(b * TB + u.pm * 256 + wr * 64 + m * 16 + fr) * D + col0;
#pragma unroll
            for (int bj = 0; bj < 2; ++bj)
#pragma unroll
                for (int n = 0; n < 2; ++n) pre[m][bj][n] = *(const f32x4*)(xin + off + bj * 128 + n * 4); }
        st1.run(acc, u, wr, wc, fr, fq, lds, wid, lane);
#pragma unroll
        for (int ai = 0; ai < 2; ++ai)
#pragma unroll
            for (int m = 0; m < 4; ++m) { const int r = ai * 128 + wr * 64 + m * 16 + fr; const float s1 = S[r]; const size_t off = (size_t)(b * TB + u.pm * 256 + r) * D + col0;
#pragma unroll
                for (int bj = 0; bj < 2; ++bj)
#pragma unroll
                    for (int n = 0; n < 2; ++n) { const f32x4 bs = pre[m][bj][n]; const f32x4 gg = *(const f32x4*)(g1 + col0 + bj * 128 + n * 4);
                        acc[ai][bj][m][n] = bs + acc[ai][bj][m][n] * s1 * gg; }
                asm volatile("" : "+v"(acc[ai][0][m][0]), "+v"(acc[ai][0][m][1]), "+v"(acc[ai][1][m][0]), "+v"(acc[ai][1][m][1]));
                if (ai == 0 && m == 3) {
                    asm volatile("" ::: "memory");
#pragma unroll
                    for (int m2 = 0; m2 < 4; ++m2) { const size_t off2 = (size_t)(b * TB + u.pm * 256 + 128 + wr * 64 + m2 * 16 + fr) * D + col0;
#pragma unroll
                        for (int bj = 0; bj < 2; ++bj)
#pragma unroll
                            for (int n = 0; n < 2; ++n) pre[m2][bj][n] = *(const f32x4*)(xin + off2 + bj * 128 + n * 4); }
                } }
        st2.run(acc, u, wr, wc, fr, fq, lds, wid, lane);
#pragma unroll
        for (int ai = 0; ai < 2; ++ai)
#pragma unroll
            for (int m = 0; m < 4; ++m) { const int r = ai * 128 + wr * 64 + m * 16 + fr; const float s2 = S[r]; const size_t off = (size_t)(b * TB + u.pm * 256 + r) * D + col0;
#pragma unroll
                for (int bj = 0; bj < 2; ++bj) { const f32x4 x0 = acc[ai][bj][m][0], x1 = acc[ai][bj][m][1];
                    *(f32x4*)(xout + off + bj * 128) = x0; *(f32x4*)(xout + off + bj * 128 + 4) = x1;
                    const f32x4 h0 = *(const f32x4*)(g2 + col0 + bj * 128), h1 = *(const f32x4*)(g2 + col0 + bj * 128 + 4);
                    st8bf(H2o + off + bj * 128, x0 * s2 * h0, x1 * s2 * h1); }
                asm volatile("" ::: "memory"); }
    }
};
struct EpiG6Fused {
    static constexpr bool PERM = true, AFTER_DRAIN = true; static constexpr int MID = 0;
    int l, b;
    __device__ __forceinline__ void fused(pg8::f32x4 (&acc)[2][2][4][2], const pg8::Unit& u, int wr, int wc, int fr, int fq, LAS unsigned char* lds, int wid, int lane) const {
        KArgs ka = (KArgs)__builtin_amdgcn_kernarg_segment_ptr(); asm volatile("" : "+s"(ka));
        unsigned char* ws = ka->ws;
        float* X = ka->out; const float* g3 = ka->in[19] + l * D;
        bf16* H2o = (bf16*)(ws + WS_H2);
        const RowStat st{(float*)(ws + WS_XB), (unsigned*)(ws + WS_CNT) + (size_t)(8 + l * 2 + b) * 4096};
        const LAS float* S = (const LAS float*)(lds + 8192);
        const int col0 = u.pn * 256 + wc * 32 + 8 * fq;
        f32x4 pre[4][2][2];
#pragma unroll
        for (int m = 0; m < 4; ++m) { const size_t off = (size_t)(b * TB + u.pm * 256 + wr * 64 + m * 16 + fr) * D + col0;
#pragma unroll
            for (int bj = 0; bj < 2; ++bj)
#pragma unroll
                for (int n = 0; n < 2; ++n) pre[m][bj][n] = *(const f32x4*)(X + off + bj * 128 + n * 4); }
        st.run(acc, u, wr, wc, fr, fq, lds, wid, lane);
#pragma unroll
        for (int ai = 0; ai < 2; ++ai)
#pragma unroll
            for (int m = 0; m < 4; ++m) { const int r = ai * 128 + wr * 64 + m * 16 + fr; const float s3 = S[r]; const size_t off = (size_t)(b * TB + u.pm * 256 + r) * D + col0;
#pragma unroll
                for (int bj = 0; bj < 2; ++bj) {
                    const f32x4 b0 = pre[m][bj][0], b1 = pre[m][bj][1];
                    const f32x4 h0 = *(const f32x4*)(g3 + col0 + bj * 128), h1 = *(const f32x4*)(g3 + col0 + bj * 128 + 4);
                    const f32x4 x0 = b0 + acc[ai][bj][m][0] * s3 * h0, x1 = b1 + acc[ai][bj][m][1] * s3 * h1;
                    *(f32x4*)(X + off + bj * 128) = x0; *(f32x4*)(X + off + bj * 128 + 4) = x1;
                    st8bf(H2o + off + bj * 128, x0, x1); }
                if (ai == 0 && m == 3) {
                    asm volatile("" ::: "memory");
#pragma unroll
                    for (int m2 = 0; m2 < 4; ++m2) { const size_t off2 = (size_t)(b * TB + u.pm * 256 + 128 + wr * 64 + m2 * 16 + fr) * D + col0;
#pragma unroll
                        for (int bj = 0; bj < 2; ++bj)
#pragma unroll
                            for (int n = 0; n < 2; ++n) pre[m2][bj][n] = *(const f32x4*)(X + off2 + bj * 128 + n * 4); }
                } }
    }
};
constexpr int PH_PER_LAYER = 18, N_PHASES = 2 * PH_PER_LAYER;
#ifndef PROBE_MASK
#define PROBE_MASK 0
#endif
__global__ void __launch_bounds__(512, 2) mega(Args a) {
    extern __shared__ __attribute__((aligned(16))) unsigned char lds_raw[];
    LAS unsigned char* lds = (LAS unsigned char*)lds_raw;
    if (threadIdx.x < 4) ((LAS unsigned*)(lds + LDS_ST))[threadIdx.x] = 0u;
    __syncthreads();
    (void)xcd_barrier_post((unsigned*)(a.ws + WS_BAR), (volatile LAS unsigned*)(lds + LDS_ST));
    int rep = 0;
    for (int st = a.ph_lo; ; ) {
        int tid = threadIdx.x; asm volatile("" : "+v"(tid));
        KArgs ka = (KArgs)__builtin_amdgcn_kernarg_segment_ptr(); asm volatile("" : "+s"(ka));
        unsigned char* ws = ka->ws; float* X = ka->out;
        int bid = blockIdx.x; asm volatile("" : "+s"(bid));
        const int lane = tid & 63, wave = __builtin_amdgcn_readfirstlane(tid >> 6);
        const int l = st / PH_PER_LAYER, idx = st % PH_PER_LAYER;
        const float* xin = l == 0 ? ka->in[0] : X;
        const bool fusedR1 = (gridDim.x == 256);
        if (fusedR1 && idx == 13) { ++st; continue; }
        const int kind = idx == 0 ? 0 : (idx <= 12 ? 1 + (idx - 1) % 6 : idx - 6);
        if (idx == 0) {
            prologue(ka, ws, l, lds, tid, wave, lane);
            rows_r0(xin, ka->in[2] + l * D, (bf16*)(ws + WS_H), 0, TB, wave, lane);
            if (fusedR1) {
                const float* pr = ka->in[1] + (size_t)l * T * PLE; bf16* pb = (bf16*)(ws + WS_PB2);
                for (size_t i = (size_t)bid * 512 + tid; i < (size_t)T * PLE / 8; i += (size_t)gridDim.x * 512) { const f32x4 a = __builtin_nontemporal_load((const f32x4*)(pr + 8 * i)), b = __builtin_nontemporal_load((const f32x4*)(pr + 8 * i + 4)); st8bf(pb + 8 * i, a, b); }
            }
        } else if (idx <= 12) {
            const int b = (idx - 1) / 6, sub = (idx - 1) % 6;
            if (sub == 0) {
                EpiG1 E{ws, l == 0 ? 1 : 0};
                run_gemm(lds, (const bf16*)(ws + WS_H), (const bf16*)(ws + W_IN), TB, NIN, D, E, tid, bid);
            } else if (sub == 1) {
                for (int it = bid; it < 8 * NSEG; it += gridDim.x) scan_p1_item(lds, ws, it, tid, wave, lane);
                for (int it = bid; it < 128 * 2; it += gridDim.x) sgu_item(lds, ws, ka->in[9] + l * SGWD, ka->in[10] + l * SGWD, ka->in[8] + l * 1024, it, tid, wave, lane);
                if (b == 0) rows_r0(xin, ka->in[2] + l * D, (bf16*)(ws + WS_H), TB, TB, wave, lane);
            } else if (sub == 2) {
                scan_combine(ws, tid);
            } else if (sub == 3) {
                for (int it = bid; it < 8 * NSEG; it += gridDim.x) scan_item<true>(lds, ws, ka->in[6] + l * D, it, tid, wave, lane);
            } else if (sub == 4) {
                { EpiRow8<FG2> E{FG2{ws}};
                  run_gemm(lds, (const bf16*)(ws + WS_AO), (const bf16*)(ws + W_A), TB, D, D, E, tid, bid); }
                { int tid2 = threadIdx.x; asm volatile("" : "+v"(tid2)); KArgs ka2 = (KArgs)__builtin_amdgcn_kernarg_segment_ptr(); asm volatile("" : "+s"(ka2)); unsigned char* ws2 = ka2->ws; int bid2 = blockIdx.x; asm volatile("" : "+s"(bid2));
                  EpiRow8<FG3> E{FG3{ws2}};
                  run_gemm(lds, (const bf16*)(ws2 + WS_BO), (const bf16*)(ws2 + W_B), TB, D, SGWD, E, tid2, bid2); }
            } else if (fusedR1) {
                EpiG4Fused E{l, b};
                run_gemm<EpiG4Fused, false>(lds, (const bf16*)(ws + WS_Q), (const bf16*)(ws + W_O), TB, D, D, E, tid, bid);
            } else {
                EpiRow8<FStore> E{FStore{ws, WS_MIX + (size_t)b * TB * D * 2}};
                run_gemm(lds, (const bf16*)(ws + WS_Q), (const bf16*)(ws + W_O), TB, D, D, E, tid, bid);
            }
        } else if (idx == 13) {
            rows_r12(xin, X, (const bf16*)(ws + WS_MIX), ka->in[14] + l * D, ka->in[15] + l * D, (bf16*)(ws + WS_H2), nullptr, nullptr, wave, lane);
        } else if (idx == 14) {
            EpiSwiglu E{ws};
            run_gemm(lds, (const bf16*)(ws + (fusedR1 ? WS_MIX : WS_H2)), (const bf16*)(ws + W_GU), T, 2 * FF, D, E, tid, bid);
        } else if (fusedR1 && (idx == 15 || idx == 16)) {
            const int b = idx - 15;
            EpiG6Fused E{l, b};
            run_gemm<EpiG6Fused, false>(lds, (const bf16*)(ws + WS_HID) + (size_t)b * TB * FF, (const bf16*)(ws + W_DN), TB, D, FF, E, tid, bid);
        } else if (idx == 15) {
            EpiRow8<FStore> E{FStore{ws, WS_MIX}};
            run_gemm(lds, (const bf16*)(ws + WS_HID), (const bf16*)(ws + W_DN), T, D, FF, E, tid, bid);
        } else if (idx == 16) {
            rows_r12(X, X, (const bf16*)(ws + WS_MIX), ka->in[19] + l * D, nullptr, (bf16*)(ws + WS_H2), ka->in[1] + (size_t)l * T * PLE, (bf16*)(ws + WS_PB), wave, lane);
        } else {
            { EpiRow8<FSig> E{FSig{ws}};
              run_gemm(lds, (const bf16*)(ws + WS_H2), (const bf16*)(ws + W_PG), T, D, D, E, tid, bid); }
            { int tid2 = threadIdx.x; asm volatile("" : "+v"(tid2)); KArgs ka2 = (KArgs)__builtin_amdgcn_kernarg_segment_ptr(); asm volatile("" : "+s"(ka2)); unsigned char* ws2 = ka2->ws; int bid2 = blockIdx.x; asm volatile("" : "+s"(bid2));
              EpiRow8<FG8> E{FG8{ws2, ka2->out}};
              run_gemm(lds, (const bf16*)(ws2 + (gridDim.x == 256 ? WS_PB2 : WS_PB)), (const bf16*)(ws2 + W_PL), T, D, PLE, E, tid2, bid2); }
        }
        if (PROBE_MASK != 0 && rep == 0 && ((PROBE_MASK >> kind) & 1)) { rep = 1; __syncthreads(); continue; }
        rep = 0;
        if (st + 1 >= ka->ph_hi) break;
        if (ka->ph_lo < 0) cg::this_grid().sync();
        else { XcdBarrier xb; xb.bar = (unsigned*)(ka->ws + WS_BAR); xb.x = xb_xcc_id(); xb.st = (volatile LAS unsigned*)(lds + LDS_ST); xcd_barrier(xb); }
        ++st;
    }
}

extern "C" void kernel_launch(void* const* d_in, const int* in_sizes, int n_in, void* d_out, int out_size, void* d_ws, size_t ws_size, hipStream_t stream) {
    static int grid = 0;
    if (grid == 0) {
        if (n_in != 22 || ws_size < WS_END) { fprintf(stderr, "kernel_launch: unexpected n_in %d / ws_size %zu (need %zu)\n", n_in, ws_size, (size_t)WS_END); grid = -1; return; }
        int dev = 0, cus = 0, per_cu = 0;
        hipGetDevice(&dev); hipDeviceGetAttribute(&cus, hipDeviceAttributeMultiprocessorCount, dev);
        hipFuncSetAttribute((const void*)mega, hipFuncAttributeMaxDynamicSharedMemorySize, LDS_BYTES);
        hipOccupancyMaxActiveBlocksPerMultiprocessor(&per_cu, (const void*)mega, 512, LDS_BYTES);
        if (per_cu < 1) per_cu = 1;
        (void)hipGetLastError();
        grid = cus * per_cu;
    }
    if (grid < 0) return;
    if (hipMemsetAsync((char*)d_ws + WS_BAR, 0, CTL_ZERO_BYTES, stream) != hipSuccess) { fprintf(stderr, "memset failed\n"); return; }
    Args a{};
    for (int i = 0; i < 22; ++i) a.in[i] = (const float*)d_in[i];
    a.out = (float*)d_out; a.ws = (unsigned char*)d_ws; a.ph_lo = 0; a.ph_hi = N_PHASES;
    void* args[] = {&a};
    hipError_t e = hipLaunchCooperativeKernel((const void*)mega, dim3(grid), dim3(512), args, LDS_BYTES, stream);
    if (e != hipSuccess) fprintf(stderr, "cooperative launch failed: %s (grid %d)\n", hipGetErrorString(e), grid);
}
```
